# Optimizing an MI355X kernel written in HIP

```python
import math
import jax
import jax.numpy as jnp
from jax import lax
import numpy as np

D_MODEL = 1024
BATCH = 2
SEQ = 8192
DEPTH = 2

GRID_W = 64
CTX_LEN = 256
HEAD_DIM = 64
ATTN_HEADS = 8
ATTN_KV_HEADS = 2
MLSTM_HEADS = 4
GDN_HEADS = 4
ATTN_W = ATTN_HEADS * HEAD_DIM
KV_W = ATTN_KV_HEADS * HEAD_DIM
MLSTM_W = MLSTM_HEADS * HEAD_DIM
GDN_W = GDN_HEADS * HEAD_DIM
MIX_W = ATTN_W + MLSTM_W + GDN_W
N_DIR = 2
CHUNK = 64
Q_BLOCK = 128
CONV_K = 5
ROPE_THETA = 10000.0
N_EXPERTS = 16
CAPACITY_FACTOR = 2
EXPERT_FF = 2048
N_MOD = 6
EPS = 1e-6
IN_SPLITS = (ATTN_W, KV_W, KV_W,
             MLSTM_W, MLSTM_W, MLSTM_W, MLSTM_W, N_DIR * MLSTM_HEADS, N_DIR * MLSTM_HEADS,
             GDN_W, GDN_W, GDN_W, GDN_W, N_DIR * GDN_HEADS, N_DIR * GDN_HEADS)
IN_W = ATTN_W + 2 * KV_W + 4 * MLSTM_W + 2 * N_DIR * MLSTM_HEADS + 4 * GDN_W + 2 * N_DIR * GDN_HEADS

kernel_name = 'hybrid_gqa_mlstm_gdn_ecmoe_dit'


def rms_norm(x, g):
    xf = x.astype(jnp.float32)
    y = xf * lax.rsqrt(jnp.mean(xf * xf, axis=-1, keepdims=True) + EPS)
    return (y * g.astype(jnp.float32)).astype(x.dtype)


def l2_norm(x):
    xf = x.astype(jnp.float32)
    return (xf * lax.rsqrt(jnp.sum(xf * xf, axis=-1, keepdims=True) + EPS)).astype(x.dtype)


def modulate(h, shift, scale):
    return h * (1 + scale) + shift


def split_cols(p):
    return jnp.split(p, np.cumsum(IN_SPLITS)[:-1].tolist(), axis=-1)


def flip_seq(t, on):
    return jnp.flip(t, axis=1) if on else t


def to_chunks(t):
    b, n, h = t.shape[:3]
    t = t.reshape(b, n // CHUNK, CHUNK, h, *t.shape[3:])
    return jnp.moveaxis(t, (1, 2), (0, 3))


def from_chunks(t):
    t = jnp.moveaxis(t, (0, 3), (1, 2))
    b, nc, l, h, d = t.shape
    return t.reshape(b, nc * l, h, d)


def axial_rope_tables(n):
    rows = n // GRID_W
    row = jnp.broadcast_to(jnp.arange(rows)[:, None], (rows, GRID_W)).reshape(-1)
    col = jnp.broadcast_to(jnp.arange(GRID_W)[None, :], (rows, GRID_W)).reshape(-1)
    n_freq = HEAD_DIM // 4
    inv = ROPE_THETA ** (-jnp.arange(n_freq, dtype=jnp.float32) / n_freq)
    ang = jnp.stack([row, col], axis=-1).astype(jnp.float32)[..., None] * inv
    return jnp.cos(ang), jnp.sin(ang)


def apply_axial_rope(x, cos, sin):
    b, n, h, d = x.shape
    xf = x.astype(jnp.float32).reshape(b, n, h, 2, 2, d // 4)
    x1, x2 = xf[..., 0, :], xf[..., 1, :]
    cs, sn = cos[:, None], sin[:, None]
    out = jnp.stack([x1 * cs - x2 * sn, x2 * cs + x1 * sn], axis=-2)
    return out.reshape(b, n, h, d).astype(x.dtype)


def attention_mixer(parts_x, parts_c, qn_g, kn_g, need_ctx):
    q_x, k_x, v_x = parts_x
    q_c, k_c, v_c = parts_c
    b, n, _ = q_x.shape
    m = q_c.shape[1]
    rep = ATTN_HEADS // ATTN_KV_HEADS
    scale = HEAD_DIM ** -0.5

    def heads(t, h):
        return t.reshape(t.shape[0], t.shape[1], h, HEAD_DIM)

    cos, sin = axial_rope_tables(n)
    qx = apply_axial_rope(rms_norm(heads(q_x, ATTN_HEADS), qn_g), cos, sin)
    kx = apply_axial_rope(rms_norm(heads(k_x, ATTN_KV_HEADS), kn_g), cos, sin)
    vx = heads(v_x, ATTN_KV_HEADS)
    kc = rms_norm(heads(k_c, ATTN_KV_HEADS), kn_g)
    vc = heads(v_c, ATTN_KV_HEADS)
    k_all = jnp.concatenate([kc, kx], axis=1)
    v_all = jnp.concatenate([vc, vx], axis=1)

    def attend(qb, kk, vv):
        s = jnp.einsum('bqgrd,bkgd->bgrqk', qb, kk).astype(jnp.float32) * scale
        p = jax.nn.softmax(s, axis=-1).astype(vv.dtype)
        return jnp.einsum('bgrqk,bkgd->bqgrd', p, vv)

    qxb = qx.reshape(b, n // Q_BLOCK, Q_BLOCK, ATTN_KV_HEADS, rep, HEAD_DIM).transpose(1, 0, 2, 3, 4, 5)
    out_x = lax.map(lambda qb: attend(qb, k_all, v_all), qxb)
    out_x = out_x.transpose(1, 0, 2, 3, 4, 5).reshape(b, n, ATTN_W)
    out_c = None
    if need_ctx:
        qc = rms_norm(heads(q_c, ATTN_HEADS), qn_g).reshape(b, m, ATTN_KV_HEADS, rep, HEAD_DIM)
        out_c = attend(qc, kc, vc).reshape(b, m, ATTN_W)
    return out_x, out_c


def mlstm_scan(q, k, v, i_pre, f_pre, state, with_out):
    causal = jnp.tril(jnp.ones((CHUNK, CHUNK), dtype=bool))

    def step(carry, inp):
        C, nv, m = carry
        qc, kc, vc, ic, fc = inp
        bcum = jnp.cumsum(jax.nn.log_sigmoid(fc), axis=-1)
        b_last = bcum[..., -1]
        w_end = b_last[..., None] - bcum + ic
        m_new = jnp.maximum(b_last + m, jnp.max(w_end, axis=-1))
        a_end = jnp.exp(w_end - m_new[..., None])
        dec = jnp.exp(b_last + m - m_new)
        C_new = dec[..., None, None] * C + jnp.einsum('bhl,bhld,bhle->bhde', a_end, kc, vc)
        n_new = dec[..., None] * nv + jnp.einsum('bhl,bhld->bhd', a_end, kc)
        if not with_out:
            return (C_new, n_new, m_new), None
        dmat = jnp.where(causal, bcum[..., :, None] - bcum[..., None, :] + ic[..., None, :], -jnp.inf)
        inter = bcum + m[..., None]
        m_t = jnp.maximum(inter, jnp.max(dmat, axis=-1))
        w_in = jnp.exp(inter - m_t)
        s = jnp.einsum('bhtd,bhsd->bhts', qc, kc) * jnp.exp(dmat - m_t[..., None])
        num = w_in[..., None] * jnp.einsum('bhtd,bhde->bhte', qc, C) + jnp.einsum('bhts,bhse->bhte', s, vc)
        den = w_in * jnp.einsum('bhtd,bhd->bht', qc, nv) + jnp.sum(s, axis=-1)
        h = num / jnp.maximum(jnp.abs(den), jnp.exp(-m_t))[..., None]
        return (C_new, n_new, m_new), h

    xs = (to_chunks(q), to_chunks(k), to_chunks(v), to_chunks(i_pre), to_chunks(f_pre))
    final, hs = lax.scan(step, state, xs)
    return final, (from_chunks(hs) if with_out else None)


def mlstm_mixer(parts_x, parts_c, i_bias, f_bias, out_g, need_ctx):
    dtype = parts_x[0].dtype

    def prep(parts):
        q, k, v, o, ig, fg = [p.astype(jnp.float32) for p in parts]
        b, n, _ = q.shape
        hd = lambda t: t.reshape(b, n, MLSTM_HEADS, HEAD_DIM)
        ig = ig.reshape(b, n, N_DIR, MLSTM_HEADS) + i_bias.astype(jnp.float32)
        fg = fg.reshape(b, n, N_DIR, MLSTM_HEADS) + f_bias.astype(jnp.float32)
        return hd(q), hd(k) * HEAD_DIM ** -0.5, hd(v), o, ig, fg

    qx, kx, vx, ox, ix, fx = prep(parts_x)
    qc, kc, vc, oc, ic, fc = prep(parts_c)
    b = qx.shape[0]
    zero = (jnp.zeros((b, MLSTM_HEADS, HEAD_DIM, HEAD_DIM), jnp.float32),
            jnp.zeros((b, MLSTM_HEADS, HEAD_DIM), jnp.float32),
            jnp.zeros((b, MLSTM_HEADS), jnp.float32))
    hx_sum, hc_sum = 0.0, 0.0
    for d in range(N_DIR):
        rv = d == 1
        st, hc = mlstm_scan(flip_seq(qc, rv), flip_seq(kc, rv), flip_seq(vc, rv),
                            flip_seq(ic[:, :, d], rv), flip_seq(fc[:, :, d], rv), zero, need_ctx)
        _, hx = mlstm_scan(flip_seq(qx, rv), flip_seq(kx, rv), flip_seq(vx, rv),
                           flip_seq(ix[:, :, d], rv), flip_seq(fx[:, :, d], rv), st, True)
        hx_sum = hx_sum + flip_seq(hx, rv)
        if need_ctx:
            hc_sum = hc_sum + flip_seq(hc, rv)

    def finish(h, o):
        bb, nn = h.shape[:2]
        return (jax.nn.sigmoid(o) * rms_norm(h, out_g).reshape(bb, nn, MLSTM_W)).astype(dtype)

    return finish(hx_sum, ox), (finish(hc_sum, oc) if need_ctx else None)


def short_conv(t, w):
    k, ch = w.shape
    return lax.conv_general_dilated(t, w.reshape(k, 1, ch).astype(t.dtype), window_strides=(1,),
                                    padding=[(k // 2, k // 2)], dimension_numbers=('NWC', 'WIO', 'NWC'),
                                    feature_group_count=ch)


def gdn_scan(q, k, v, g, beta, state, with_out):
    incl = jnp.tril(jnp.ones((CHUNK, CHUNK), dtype=bool))
    strict = jnp.tril(jnp.ones((CHUNK, CHUNK), dtype=bool), -1)
    eye = jnp.eye(CHUNK, dtype=jnp.float32)

    def step(S, inp):
        qc, kc, vc, gc, bc = inp
        G = jnp.cumsum(gc, axis=-1)
        decay = jnp.where(incl, jnp.exp(jnp.where(incl, G[..., :, None] - G[..., None, :], 0.0)), 0.0)
        kb = kc * bc[..., None]
        A = eye + jnp.where(strict, jnp.einsum('bhid,bhjd->bhij', kb, kc) * decay, 0.0)
        rhs = jnp.concatenate([vc * bc[..., None], kb * jnp.exp(G)[..., None]], axis=-1)
        sol = lax.linalg.triangular_solve(A, rhs, left_side=True, lower=True, unit_diagonal=True)
        u, w = sol[..., :HEAD_DIM], sol[..., HEAD_DIM:]
        v_new = u - jnp.einsum('bhld,bhde->bhle', w, S)
        G_last = G[..., -1]
        S_new = jnp.exp(G_last)[..., None, None] * S + jnp.einsum(
            'bhld,bhle->bhde', kc * jnp.exp(G_last[..., None] - G)[..., None], v_new)
        if not with_out:
            return S_new, None
        o = jnp.einsum('bhld,bhde->bhle', qc * jnp.exp(G)[..., None], S) + jnp.einsum(
            'bhts,bhse->bhte', jnp.einsum('bhtd,bhsd->bhts', qc, kc) * decay, v_new)
        return S_new, o

    xs = (to_chunks(q), to_chunks(k), to_chunks(v), to_chunks(g), to_chunks(beta))
    final, os_ = lax.scan(step, state, xs)
    return final, (from_chunks(os_) if with_out else None)


def gdn_mixer(parts_x, parts_c, conv_w, a_log, dt_bias, out_g, need_ctx):
    dtype = parts_x[0].dtype

    def prep(parts):
        q, k, v, z, a, bt = parts
        b, n, _ = q.shape
        qkv = jax.nn.silu(short_conv(jnp.concatenate([q, k, v], axis=-1), conv_w)).astype(jnp.float32)
        q, k, v = jnp.split(qkv, 3, axis=-1)
        hd = lambda t: t.reshape(b, n, GDN_HEADS, HEAD_DIM)
        q = l2_norm(hd(q)) * HEAD_DIM ** -0.5
        k = l2_norm(hd(k))
        g = -jnp.exp(a_log.astype(jnp.float32)) * jax.nn.softplus(
            a.astype(jnp.float32).reshape(b, n, N_DIR, GDN_HEADS) + dt_bias.astype(jnp.float32))
        beta = jax.nn.sigmoid(bt.astype(jnp.float32).reshape(b, n, N_DIR, GDN_HEADS))
        return q, k, hd(v), z, g, beta

    qx, kx, vx, zx, gx, bx = prep(parts_x)
    qc, kc, vc, zc, gc, bc = prep(parts_c)
    b = qx.shape[0]
    zero = jnp.zeros((b, GDN_HEADS, HEAD_DIM, HEAD_DIM), jnp.float32)
    ox_sum, oc_sum = 0.0, 0.0
    for d in range(N_DIR):
        rv = d == 1
        st, oc = gdn_scan(flip_seq(qc, rv), flip_seq(kc, rv), flip_seq(vc, rv),
                          flip_seq(gc[:, :, d], rv), flip_seq(bc[:, :, d], rv), zero, need_ctx)
        _, ox = gdn_scan(flip_seq(qx, rv), flip_seq(kx, rv), flip_seq(vx, rv),
                         flip_seq(gx[:, :, d], rv), flip_seq(bx[:, :, d], rv), st, True)
        ox_sum = ox_sum + flip_seq(ox, rv)
        if need_ctx:
            oc_sum = oc_sum + flip_seq(oc, rv)

    def finish(o, z):
        bb, nn = o.shape[:2]
        return (rms_norm(o, out_g).reshape(bb, nn, GDN_W) * jax.nn.silu(z.astype(jnp.float32))).astype(dtype)

    return finish(ox_sum, zx), (finish(oc_sum, zc) if need_ctx else None)


def expert_choice_ffn(h, router_w, w1, w3, w2):
    b, n, _ = h.shape
    cap = CAPACITY_FACTOR * n // N_EXPERTS
    aff = jax.nn.softmax((h @ router_w).astype(jnp.float32), axis=-1)
    vals, idx = lax.top_k(jnp.swapaxes(aff, 1, 2), cap)
    bidx = jnp.arange(b)[:, None, None]
    xg = h[bidx, idx]
    hid = jax.nn.silu(jnp.einsum('becd,edf->becf', xg, w1)) * jnp.einsum('becd,edf->becf', xg, w3)
    y = jnp.einsum('becf,efd->becd', hid, w2) * vals[..., None].astype(h.dtype)
    return jnp.zeros_like(h).at[bidx, idx].add(y)


def setup_inputs(seed: int = 0) -> dict:
    key = jax.random.key(seed)
    ks = jax.random.split(key, 26)
    f32 = jnp.float32
    L, D, E, F = DEPTH, D_MODEL, N_EXPERTS, EXPERT_FF
    nrm = lambda k, shape, s: jax.random.normal(k, shape, f32) * s
    gain = lambda k, shape: 1.0 + 0.02 * jax.random.normal(k, shape, f32)
    dt = jnp.exp(jax.random.uniform(ks[14], (L, N_DIR, GDN_HEADS), f32, math.log(1e-3), math.log(1e-1)))
    return {
        'x': nrm(ks[0], (BATCH, SEQ, D), 1.0),
        'c': nrm(ks[1], (BATCH, D), 1.0),
        'ctx': nrm(ks[2], (BATCH, CTX_LEN, D), 1.0),
        'c_ctx': nrm(ks[3], (D,), 1.0),
        'mod_w': nrm(ks[4], (L, D, N_MOD * D), 0.5 * D ** -0.5),
        'mod_b': nrm(ks[5], (L, N_MOD * D), 0.02),
        'norm1_g': gain(ks[6], (L, D)),
        'w_in': nrm(ks[7], (L, D, IN_W), D ** -0.5),
        'q_norm_g': gain(ks[8], (L, HEAD_DIM)),
        'k_norm_g': gain(ks[9], (L, HEAD_DIM)),
        'mlstm_i_bias': nrm(ks[10], (L, N_DIR, MLSTM_HEADS), 0.1),
        'mlstm_f_bias': jnp.linspace(3.0, 6.0, MLSTM_HEADS, dtype=f32) + nrm(ks[11], (L, N_DIR, MLSTM_HEADS), 0.1),
        'mlstm_out_g': gain(ks[12], (L, MLSTM_HEADS, HEAD_DIM)),
        'gdn_conv_w': nrm(ks[13], (L, CONV_K, 3 * GDN_W), CONV_K ** -0.5),
        'gdn_a_log': jnp.log(jax.random.uniform(ks[15], (L, N_DIR, GDN_HEADS), f32, 1.0, 16.0)),
        'gdn_dt_bias': dt + jnp.log(-jnp.expm1(-dt)),
        'gdn_out_g': gain(ks[16], (L, HEAD_DIM)),
        'w_out': nrm(ks[17], (L, MIX_W, D), MIX_W ** -0.5),
        'norm2_g': gain(ks[18], (L, D)),
        'router_w': nrm(ks[19], (L, D, E), D ** -0.5),
        'w1': nrm(ks[20], (L, E, D, F), D ** -0.5),
        'w3': nrm(ks[21], (L, E, D, F), D ** -0.5),
        'w2': nrm(ks[22], (L, E, F, D), F ** -0.5),
    }


def reference(x, c, ctx, c_ctx, mod_w, mod_b, norm1_g, w_in, q_norm_g, k_norm_g,
              mlstm_i_bias, mlstm_f_bias, mlstm_out_g, gdn_conv_w, gdn_a_log, gdn_dt_bias,
              gdn_out_g, w_out, norm2_g, router_w, w1, w3, w2):
    xc = ctx
    for l in range(DEPTH):
        need_ctx = l < DEPTH - 1
        mod = (jax.nn.silu(c) @ mod_w[l] + mod_b[l])[:, None, :]
        modc = jax.nn.silu(c_ctx) @ mod_w[l] + mod_b[l]
        sh1, sc1, g1, sh2, sc2, g2 = jnp.split(mod, N_MOD, axis=-1)
        sh1c, sc1c, g1c, sh2c, sc2c, g2c = jnp.split(modc, N_MOD, axis=-1)

        px = split_cols(modulate(rms_norm(x, norm1_g[l]), sh1, sc1) @ w_in[l])
        pc = split_cols(modulate(rms_norm(xc, norm1_g[l]), sh1c, sc1c) @ w_in[l])
        ax, ac = attention_mixer(px[0:3], pc[0:3], q_norm_g[l], k_norm_g[l], need_ctx)
        mx, mc = mlstm_mixer(px[3:9], pc[3:9], mlstm_i_bias[l], mlstm_f_bias[l], mlstm_out_g[l], need_ctx)
        gx, gc = gdn_mixer(px[9:15], pc[9:15], gdn_conv_w[l], gdn_a_log[l], gdn_dt_bias[l], gdn_out_g[l], need_ctx)

        x = x + g1 * (jnp.concatenate([ax, mx, gx], axis=-1) @ w_out[l])
        x = x + g2 * expert_choice_ffn(modulate(rms_norm(x, norm2_g[l]), sh2, sc2),
                                       router_w[l], w1[l], w3[l], w2[l])
        if need_ctx:
            xc = xc + g1c * (jnp.concatenate([ac, mc, gc], axis=-1) @ w_out[l])
            xc = xc + g2c * expert_choice_ffn(modulate(rms_norm(xc, norm2_g[l]), sh2c, sc2c),
                                              router_w[l], w1[l], w3[l], w2[l])
    return x
```

```cpp
#include <hip/hip_runtime.h>
#include <hip/hip_cooperative_groups.h>
#include <hip/hip_bf16.h>
#include <cmath>
#include <stdint.h>
#include <stdio.h>

#define LAS __attribute__((address_space(3)))
#define GAS __attribute__((address_space(1)))
typedef unsigned short bf16_t;
typedef short bf16x8 __attribute__((ext_vector_type(8)));
typedef short s16x4 __attribute__((ext_vector_type(4)));
typedef float f32x4 __attribute__((ext_vector_type(4)));
typedef float f32x16 __attribute__((ext_vector_type(16)));
typedef float f32x2 __attribute__((ext_vector_type(2)));
typedef __bf16 bf16x2_t __attribute__((ext_vector_type(2)));
typedef unsigned u32x4 __attribute__((ext_vector_type(4)));
typedef unsigned u32x2 __attribute__((ext_vector_type(2)));

constexpr int NB = 2, SEQ = 8192, DM = 1024, CTXL = 256;
constexpr int NLAT = NB * SEQ, NCTX = NB * CTXL, NROW = NLAT + NCTX;
constexpr int NPC = 2816, NGC = 32, INW = 2848;
constexpr int NE = 16, FF = 2048, CAPL = 1024, CAPC = 32;
constexpr int KPOS = CTXL + SEQ;
constexpr int NMOD = 6 * DM;
constexpr int NHIDROW = NB * NE * CAPL + NB * NE * CAPC;
constexpr float EPS = 1e-6f;
constexpr float QSCALE = 0.125f * 1.4426950408889634f;

constexpr size_t MiB = 1u << 20;
constexpr size_t OFF_CTL = 0;
constexpr size_t OFF_MODV = 1 * MiB;
constexpr size_t OFF_WG = OFF_MODV + 256 * 1024;
constexpr size_t OFF_RWT = OFF_WG + 128 * 1024;
constexpr size_t OFF_ROPE = OFF_RWT + 64 * 1024;
constexpr size_t OFF_WTIN = 2 * MiB;
constexpr size_t OFF_WTOUT = 14 * MiB;
constexpr size_t OFF_WT13 = 18 * MiB;
constexpr size_t OFF_WT2 = 274 * MiB;
constexpr size_t OFF_X1 = 402 * MiB;
constexpr int ATT_NSU = 80;
constexpr size_t OFF_APO = OFF_X1;
constexpr size_t OFF_AML = OFF_X1 + 16 * MiB;
constexpr size_t OFF_X2 = 468 * MiB;
constexpr size_t OFF_XA = 534 * MiB;
constexpr size_t OFF_Y = 567 * MiB;
constexpr size_t OFF_AFF = 600 * MiB;
constexpr size_t OFF_IDX = 602 * MiB;
constexpr size_t OFF_VALS = 603 * MiB;
constexpr size_t OFF_SLOT = 604 * MiB;
constexpr size_t OFF_S0 = 606 * MiB;
constexpr size_t OFF_PB = OFF_S0;
constexpr size_t OFF_G = OFF_S0 + 92 * MiB;
constexpr size_t OFF_QB = OFF_S0 + 95 * MiB;
constexpr size_t OFF_KB = OFF_S0 + 112 * MiB;
constexpr size_t OFF_VT = OFF_S0 + 117 * MiB;
constexpr size_t OFF_MLH = OFF_S0 + 122 * MiB;
constexpr size_t OFF_GDO = OFF_S0 + 155 * MiB;
constexpr size_t OFF_GQB = OFF_S0 + 188 * MiB;
constexpr size_t OFF_GKB = OFF_S0 + 197 * MiB;
constexpr size_t OFF_GVB = OFF_S0 + 206 * MiB;
constexpr int NCHUNK = KPOS / 64;
constexpr int NUNIT = 16 * NCHUNK;
constexpr size_t OFF_MLNUM = OFF_S0 + 215 * MiB;
constexpr size_t OFF_MLKL = OFF_S0 + 248 * MiB;
constexpr size_t OFF_MLVEC = OFF_S0 + 281 * MiB;
constexpr size_t OFF_GDMW = OFF_S0 + 284 * MiB;
constexpr size_t OFF_GDN = OFF_S0 + 301 * MiB;
constexpr size_t OFF_GDQE = OFF_S0 + 334 * MiB;
constexpr size_t OFF_GDOL = OFF_S0 + 351 * MiB;
constexpr size_t OFF_GDSC = OFF_S0 + 384 * MiB;
constexpr size_t OFF_HID = OFF_S0;
constexpr size_t OFF_YE = OFF_S0 + 132 * MiB;
constexpr size_t OFF_YEC = OFF_S0 + 200 * MiB;
constexpr size_t OFF_XPC = OFF_S0 + 208 * MiB;
constexpr size_t OFF_MLQP = OFF_S0 + 385 * MiB;
constexpr size_t WS_NEED = OFF_S0 + 402 * MiB;

constexpr int LDS_MAIN = 8 * 18176;
constexpr int LDS_BYTES = LDS_MAIN + 16;
constexpr int CTL_BYTES = 32768;

struct Params {
    const float* in[23];
    float* out;
    unsigned char* ws;
    int phase, layer;
};
enum { I_X = 0, I_C, I_CTX, I_CCTX, I_MODW, I_MODB, I_N1G, I_WIN, I_QNG, I_KNG, I_MLIB, I_MLFB, I_MLOG, I_GCW, I_GAL, I_GDT, I_GOG, I_WOUT, I_N2G, I_RW, I_W1, I_W3, I_W2 };

typedef const __attribute__((address_space(4))) Params* KParams;
__device__ __forceinline__ Params load_params() {
    Params r{};
#if defined(__HIP_DEVICE_COMPILE__)
    const __attribute__((address_space(4))) unsigned long long* s = (const __attribute__((address_space(4))) unsigned long long*)__builtin_amdgcn_kernarg_segment_ptr();
    asm volatile("" : "+s"(s));
    unsigned long long* d = (unsigned long long*)&r;
#pragma unroll
    for (unsigned i = 0; i < sizeof(Params) / 8; ++i) d[i] = s[i];
#endif
    return r;
}

#define PHASE_IDS() int wv_ = __builtin_amdgcn_readfirstlane(wv); asm volatile("" : "+s"(wv_)); int tid_; { int l_; asm volatile("v_mbcnt_lo_u32_b32 %0, -1, 0\n\tv_mbcnt_hi_u32_b32 %0, -1, %0" : "=v"(l_)); tid_ = wv_ * 64 + l_; } int bid_ = blockIdx.x; asm volatile("" : "+s"(bid_)); int nblk_ = gridDim.x; asm volatile("" : "+s"(nblk_));
__device__ __forceinline__ unsigned pk_bf16(float lo, float hi) { f32x2 v = {lo, hi}; bf16x2_t b = __builtin_convertvector(v, bf16x2_t); return __builtin_bit_cast(unsigned, b); }
template <int K> __device__ __forceinline__ float xor_lane(float v) {
    if constexpr (K == 32) { auto rr = __builtin_amdgcn_permlane32_swap(__builtin_bit_cast(unsigned, v), __builtin_bit_cast(unsigned, v), false, false);
        const unsigned lo = rr[0], hi = rr[1]; const unsigned own = __builtin_bit_cast(unsigned, v);
        return __builtin_bit_cast(float, (lo ^ hi) ^ own); }
    else if constexpr (K == 1) return __builtin_bit_cast(float, __builtin_amdgcn_update_dpp(0, __builtin_bit_cast(int, v), 0xB1, 0xF, 0xF, true));
    else if constexpr (K == 2) return __builtin_bit_cast(float, __builtin_amdgcn_update_dpp(0, __builtin_bit_cast(int, v), 0x4E, 0xF, 0xF, true));
    else return __builtin_bit_cast(float, __builtin_amdgcn_ds_swizzle(__builtin_bit_cast(int, v), (K << 10) | 0x1f));
}
__device__ __forceinline__ float dpp_hmirror(float v) { return __builtin_bit_cast(float, __builtin_amdgcn_update_dpp(0, __builtin_bit_cast(int, v), 0x141, 0xF, 0xF, true)); }
__device__ __forceinline__ float dpp_mirror(float v) { return __builtin_bit_cast(float, __builtin_amdgcn_update_dpp(0, __builtin_bit_cast(int, v), 0x140, 0xF, 0xF, true)); }
__device__ __forceinline__ float wave_sum(float v) {
    v += xor_lane<1>(v); v += xor_lane<2>(v); v += xor_lane<4>(v); v += xor_lane<8>(v); v += xor_lane<16>(v); v += xor_lane<32>(v);
    return v;
}
__device__ __forceinline__ float siluf(float x) { return x / (1.f + expf(-x)); }
__device__ __forceinline__ float fsilu(float x) { return x * __builtin_amdgcn_rcpf(1.f + __builtin_amdgcn_exp2f(-1.4426950408889634f * x)); }
__device__ __forceinline__ float sigmoidf_(float x) { return 1.f / (1.f + expf(-x)); }
__device__ __forceinline__ float softplusf_(float x) { return fmaxf(x, 0.f) + log1pf(expf(-fabsf(x))); }
__device__ __forceinline__ float logsigmoidf_(float x) { return fminf(x, 0.f) - log1pf(expf(-fabsf(x))); }
__device__ __forceinline__ float bf2f(bf16_t v) { return __uint_as_float((unsigned)v << 16); }
__device__ __forceinline__ bf16_t f2bf(float v) { return (bf16_t)(pk_bf16(v, 0.f) & 0xffffu); }
__device__ __forceinline__ float rdlane(float v, int l) { return __builtin_bit_cast(float, __builtin_amdgcn_readlane(__builtin_bit_cast(int, v), l)); }

__device__ __forceinline__ const float* xin_row(const Params& p, int layer, int r) {
    if (layer == 0) return r < NLAT ? p.in[I_X] + (size_t)r * DM : p.in[I_CTX] + (size_t)(r - NLAT) * DM;
    return (const float*)(p.ws + OFF_X2) + (size_t)r * DM;
}
__device__ __forceinline__ int row_sel(int r) { return r < NLAT ? (r >> 13) : 2; }

#define XB_TMO      128
#define XB_XCNT(j)  (256  + 64 * (j))
#define XB_XSUB(j)  (1280 + 64 * (j))
#define XB_XGEN(j)  (2304 + 64 * (j))
#define XB_TOP      3328
#define XB_TOPGEN   3392
#define XCD_BAR_WORDS 3456
#define XB_SPIN_CAP (1u << 20)
constexpr size_t OFF_BAR = OFF_CTL + 4096;
__device__ __forceinline__ unsigned xb_ld(unsigned* p)              { return __hip_atomic_load(p, __ATOMIC_RELAXED, __HIP_MEMORY_SCOPE_AGENT); }
__device__ __forceinline__ unsigned xb_add(unsigned* p, unsigned v) { return __hip_atomic_fetch_add(p, v, __ATOMIC_RELAXED, __HIP_MEMORY_SCOPE_AGENT); }
__device__ __forceinline__ unsigned xb_xcc_id() { return (unsigned)__builtin_amdgcn_s_getreg((3 << 11) | 20) & 0xFu; }
#define XB_SPIN(cond, bar) do { unsigned _sp = 0; while (cond) { __builtin_amdgcn_s_sleep(1); \
    if ((++_sp & 255u) == 0u) { if (xb_ld(&(bar)[XB_TMO])) break; if (_sp > XB_SPIN_CAP) { atomicAdd(&(bar)[XB_TMO], 1u); break; } } } } while (0)

template <class RowMap>
__device__ __forceinline__ void transpose_item(const float* W, int N, int k0, int n0, bf16_t* WT, int K, LAS float* scr, int lane, RowMap rowmap) {
    {
        const int nn = (lane & 15) * 4;
        const float* src = W + (size_t)(k0 + (lane >> 4)) * N + n0 + nn;
        f32x4 v[16];
#pragma unroll
        for (int i = 0; i < 16; ++i) v[i] = __builtin_nontemporal_load((const f32x4*)(src + (size_t)(4 * i) * N));
#pragma unroll
        for (int i = 0; i < 16; ++i) { LAS float* s = scr + (4 * i + (lane >> 4)) * 65 + nn; s[0] = v[i].x; s[1] = v[i].y; s[2] = v[i].z; s[3] = v[i].w; }
    }
    asm volatile("s_waitcnt lgkmcnt(0)" ::: "memory");
    const int c = lane & 7;
#pragma unroll
    for (int j = 0; j < 8; ++j) {
        const int n = (lane >> 3) + 8 * j; const LAS float* s = scr + (8 * c) * 65 + n;
        u32x4 o; o.x = pk_bf16(s[0 * 65], s[1 * 65]); o.y = pk_bf16(s[2 * 65], s[3 * 65]); o.z = pk_bf16(s[4 * 65], s[5 * 65]); o.w = pk_bf16(s[6 * 65], s[7 * 65]);
        const int orow = rowmap(n0 + n);
        if (orow >= 0) *(u32x4*)(WT + (size_t)orow * K + k0 + 8 * c) = o;
    }
    asm volatile("s_waitcnt lgkmcnt(0)" ::: "memory");
}
__device__ __forceinline__ void ph_convert(int wv, LAS unsigned char* lds) {
    const Params p = load_params();
    PHASE_IDS();
    const int tid = tid_, lane = tid & 63, wave = tid >> 6;
    LAS float* scr = (LAS float*)(lds + wave * 16640);
    const int gw = bid_ * 8 + wave, NGW = nblk_ * 8;
    constexpr int I_IN = 16 * 45, I_OUT = 16 * 16, I_E = 512, PER_LAYER = I_IN + I_OUT + 3 * NE * I_E;
    for (int it = gw; it < 2 * PER_LAYER; it += NGW) {
        const int l = it / PER_LAYER; int r = it % PER_LAYER;
        if (r < I_IN) {
            const int kb = r / 45, nb = r % 45;
            const int n0 = nb < 44 ? nb * 64 : INW - 64;
            transpose_item(p.in[I_WIN] + (size_t)l * DM * INW, INW, kb * 64, n0, (bf16_t*)(p.ws + OFF_WTIN) + (size_t)l * NPC * DM, DM, scr, lane,
                           [](int c) { return c < 1792 ? c : (c < 1808 ? -1 : (c < 2832 ? c - 16 : -1)); });
            continue;
        }
        r -= I_IN;
        if (r < I_OUT) {
            const int kb = r / 16, nb = r % 16;
            transpose_item(p.in[I_WOUT] + (size_t)l * DM * DM, DM, kb * 64, nb * 64, (bf16_t*)(p.ws + OFF_WTOUT) + (size_t)l * DM * DM, DM, scr, lane, [](int c) { return c; });
            continue;
        }
        r -= I_OUT;
        if (r < NE * I_E) {
            const int e = r / I_E, rr = r % I_E, kb = rr / 32, nb = rr % 32;
            transpose_item(p.in[I_W1] + ((size_t)l * NE + e) * DM * FF, FF, kb * 64, nb * 64, (bf16_t*)(p.ws + OFF_WT13) + ((size_t)l * NE + e) * 4096 * DM, DM, scr, lane,
                           [](int f) { return (f >> 7) * 256 + (f & 127); });
            continue;
        }
        r -= NE * I_E;
        if (r < NE * I_E) {
            const int e = r / I_E, rr = r % I_E, kb = rr / 32, nb = rr % 32;
            transpose_item(p.in[I_W3] + ((size_t)l * NE + e) * DM * FF, FF, kb * 64, nb * 64, (bf16_t*)(p.ws + OFF_WT13) + ((size_t)l * NE + e) * 4096 * DM, DM, scr, lane,
                           [](int f) { return (f >> 7) * 256 + 128 + (f & 127); });
            continue;
        }
        r -= NE * I_E;
        {
            const int e = r / I_E, rr = r % I_E, kb = rr / 16, nb = rr % 16;
            transpose_item(p.in[I_W2] + ((size_t)l * NE + e) * FF * DM, DM, kb * 64, nb * 64, (bf16_t*)(p.ws + OFF_WT2) + ((size_t)l * NE + e) * DM * FF, FF, scr, lane, [](int c) { return c; });
        }
    }
    bf16_t* WGt = (bf16_t*)(p.ws + OFF_WG); bf16_t* RWt = (bf16_t*)(p.ws + OFF_RWT);
    for (int i = bid_ * 512 + tid; i < 2 * NGC * DM; i += nblk_ * 512) {
        const int l = i / (NGC * DM), j = (i / DM) % NGC, k = i % DM;
        const int gc = j < 16 ? 1792 + j : 2832 + (j - 16);
        WGt[i] = f2bf(p.in[I_WIN][((size_t)l * DM + k) * INW + gc]);
    }
    for (int i = bid_ * 512 + tid; i < 2 * NE * DM; i += nblk_ * 512) {
        const int l = i / (NE * DM), e = (i / DM) % NE, k = i % DM;
        RWt[i] = f2bf(p.in[I_RW][((size_t)l * DM + k) * NE + e]);
    }
}

__device__ __forceinline__ void ph_mod(int wv, LAS unsigned char* lds) {
    const Params p = load_params();
    int wv_ = __builtin_amdgcn_readfirstlane(wv); asm volatile("" : "+s"(wv_)); int tid_; { int l_; asm volatile("v_mbcnt_lo_u32_b32 %0, -1, 0\n\tv_mbcnt_hi_u32_b32 %0, -1, %0" : "=v"(l_)); tid_ = wv_ * 64 + l_; } int bid_ = blockIdx.x; asm volatile("" : "+s"(bid_)); int nblk_ = gridDim.x; asm volatile("" : "+s"(nblk_));
    const int tid = tid_, lane = tid & 63, wave = tid >> 6;
    LAS float* sl = (LAS float*)lds;
    LAS float* red = sl + 3 * DM;
    for (int i = tid; i < 3 * DM; i += 512) {
        const int v = i / DM, k = i % DM;
        const float cv = v < 2 ? p.in[I_C][v * DM + k] : p.in[I_CCTX][k];
        sl[i] = siluf(cv);
    }
    __syncthreads();
    if (bid_ == nblk_ - 1) {
        float* RT = (float*)(p.ws + OFF_ROPE);
        for (int i = tid; i < 128 * 16; i += 512) { const float ang = (float)(i >> 4) * exp2f(-(float)(i & 15) * (13.287712379549449f / 16.f)); RT[i] = cosf(ang); RT[2048 + i] = sinf(ang); }
    }
    float* MODV = (float*)(p.ws + OFF_MODV);
    for (int item = bid_; item < 2 * 96; item += nblk_) {
        const int l = item / 96, col = (item % 96) * 64 + lane;
        const float* W = p.in[I_MODW] + (size_t)l * DM * NMOD + col;
        float a0 = 0.f, a1 = 0.f, a2 = 0.f;
        const int kb = wave * 128;
        for (int k0 = kb; k0 < kb + 128; k0 += 64) {
            float w[64];
#pragma unroll
            for (int i = 0; i < 64; ++i) w[i] = __builtin_nontemporal_load(W + (size_t)(k0 + i) * NMOD);
#pragma unroll
            for (int i = 0; i < 64; ++i) { a0 += sl[k0 + i] * w[i]; a1 += sl[DM + k0 + i] * w[i]; a2 += sl[2 * DM + k0 + i] * w[i]; }
        }
        red[(wave * 3 + 0) * 64 + lane] = a0; red[(wave * 3 + 1) * 64 + lane] = a1; red[(wave * 3 + 2) * 64 + lane] = a2;
        __syncthreads();
        if (wave < 3) {
            float s = 0.f;
#pragma unroll
            for (int w = 0; w < 8; ++w) s += red[(w * 3 + wave) * 64 + lane];
            MODV[((size_t)l * 3 + wave) * NMOD + col] = s + p.in[I_MODB][(size_t)l * NMOD + col];
        }
        __syncthreads();
    }
}

template <int NB>
__device__ __forceinline__ void skinny_proj(const GAS bf16_t* A16, const GAS bf16_t* Bt, int lane, f32x4 (&acc)[NB]) {
    const GAS bf16_t* ap = A16 + (size_t)(lane & 15) * DM + 8 * (lane >> 4);
    const GAS bf16_t* bp = Bt + (size_t)(lane & 15) * DM + 8 * (lane >> 4);
#pragma unroll
    for (int nb = 0; nb < NB; ++nb) acc[nb] = (f32x4){0.f, 0.f, 0.f, 0.f};
#pragma unroll 4
    for (int s = 0; s < DM / 32; ++s) {
        const bf16x8 a = *(const GAS bf16x8*)(ap + 32 * s);
#pragma unroll
        for (int nb = 0; nb < NB; ++nb) acc[nb] = __builtin_amdgcn_mfma_f32_16x16x32_bf16(a, *(const GAS bf16x8*)(bp + (size_t)nb * 16 * DM + 32 * s), acc[nb], 0, 0, 0);
    }
}
__device__ __forceinline__ void ph_norm1(int wv, int layer) {
    const Params p = load_params();
    PHASE_IDS();
    const int tid = tid_, lane = tid & 63, wave = tid >> 6;
    const int gw = bid_ * 8 + wave, NGW = nblk_ * 8;
    const float* MODV = (const float*)(p.ws + OFF_MODV) + (size_t)layer * 3 * NMOD;
    const float* ng = p.in[I_N1G] + (size_t)layer * DM;
    GAS bf16_t* XA = (GAS bf16_t*)(p.ws + OFF_XA);
    const GAS bf16_t* WGt = (const GAS bf16_t*)(p.ws + OFF_WG) + (size_t)layer * NGC * DM;
    GAS float* G = (GAS float*)(p.ws + OFF_G);
    for (int task = wave * nblk_ + bid_; task < NROW / 16; task += NGW) {
        const int row0 = task * 16;
        const float* mv = MODV + (size_t)row_sel(row0) * NMOD;
        f32x4 ga[4], sh[4];
#pragma unroll
        for (int j = 0; j < 4; ++j) {
            const int col = 4 * lane + 256 * j;
            const f32x4 g = *(const f32x4*)(ng + col), sc = *(const f32x4*)(mv + DM + col);
            sh[j] = *(const f32x4*)(mv + col);
            ga[j] = g * (sc + (f32x4){1.f, 1.f, 1.f, 1.f});
        }
#pragma unroll 1
        for (int rb = 0; rb < 16; rb += 4) {
            f32x4 v[4][4];
#pragma unroll
            for (int q = 0; q < 4; ++q) {
                const float* xr = xin_row(p, layer, row0 + rb + q);
#pragma unroll
                for (int j = 0; j < 4; ++j) v[q][j] = *(const f32x4*)(xr + 4 * lane + 256 * j);
            }
#pragma unroll
            for (int q = 0; q < 4; ++q) {
                float ss = 0.f;
#pragma unroll
                for (int j = 0; j < 4; ++j) ss += v[q][j].x * v[q][j].x + v[q][j].y * v[q][j].y + v[q][j].z * v[q][j].z + v[q][j].w * v[q][j].w;
                const float rstd = rsqrtf(wave_sum(ss) * (1.f / DM) + EPS);
#pragma unroll
                for (int j = 0; j < 4; ++j) {
                    const f32x4 h = v[q][j] * rstd * ga[j] + sh[j];
                    u32x2 o; o.x = pk_bf16(h.x, h.y); o.y = pk_bf16(h.z, h.w);
                    *(GAS u32x2*)(XA + (size_t)(row0 + rb + q) * DM + 4 * lane + 256 * j) = o;
                }
            }
        }
        __builtin_amdgcn_fence(__ATOMIC_RELEASE, "workgroup"); __builtin_amdgcn_fence(__ATOMIC_ACQUIRE, "workgroup");
        f32x4 acc[2];
        skinny_proj<2>(XA + (size_t)row0 * DM, WGt, lane, acc);
#pragma unroll
        for (int nb = 0; nb < 2; ++nb)
#pragma unroll
            for (int i = 0; i < 4; ++i) G[(size_t)(row0 + 4 * (lane >> 4) + i) * NGC + 16 * nb + (lane & 15)] = acc[nb][i];
    }
}

namespace g8 {
constexpr int HTB = 128 * 64 * 2;
__device__ __forceinline__ int lds_byte(int r, int c) { const int st = (r >> 4) * 2 + (c >> 5), rr = r & 15, cc = c & 31, ob = rr * 64 + cc * 2; return st * 1024 + (ob ^ (((ob >> 9) & 1) << 5)); }
__device__ __forceinline__ void stage_rc(int b, int& R, int& C) { const int st = b / 1024, sb = b % 1024, swz = sb ^ (((sb >> 9) & 1) << 5); R = (st >> 1) * 16 + swz / 64; C = (st & 1) * 32 + (swz % 64) / 2; }

template <class Epi>
__device__ __forceinline__ void gemm_unit(const int tid, LAS unsigned char* lds, const char* Ab, const unsigned (&voA)[2][2], const char* Bb, const unsigned (&voB)[2][2], int nt, const Epi& epi) {
    const int wid = __builtin_amdgcn_readfirstlane(tid >> 6), lane = tid & 63, wr = wid >> 2, wc = wid & 3, fr = lane & 15, fq = lane >> 4;
    const unsigned ldsw = (unsigned)wid * 1024u;
    const int aoff = lds_byte(wr * 64 + fr, fq * 8), boff = lds_byte(wc * 32 + fr, fq * 8);
#define G8_SA(b, h) (((b) * 2 + (h)) * HTB)
#define G8_SB(b, h) ((4 + (b) * 2 + (h)) * HTB)
#define G8_STAGE(bufoff, gbase, voff, kt) do { _Pragma("unroll") for (int _i = 0; _i < 2; ++_i) \
        __builtin_amdgcn_global_load_lds((const unsigned*)((gbase) + (voff)[_i] + (size_t)(kt) * 128), (LAS unsigned*)(lds + (bufoff) + ldsw + _i * 8192), 16, 0, 0); } while (0)
#define G8_LDA(dst, b, h) do { _Pragma("unroll") for (int m = 0; m < 4; ++m) _Pragma("unroll") for (int k = 0; k < 2; ++k) dst[m][k] = *(const LAS bf16x8*)(lds + G8_SA(b, h) + aoff + m * 2048 + k * 1024); } while (0)
#define G8_LDB(dst, b, h) do { _Pragma("unroll") for (int n = 0; n < 2; ++n) _Pragma("unroll") for (int k = 0; k < 2; ++k) dst[n][k] = *(const LAS bf16x8*)(lds + G8_SB(b, h) + boff + n * 2048 + k * 1024); } while (0)
#define G8_MMA(ai, bj, At, Bt) do { __builtin_amdgcn_s_setprio(1); _Pragma("unroll") for (int m = 0; m < 4; ++m) _Pragma("unroll") for (int n = 0; n < 2; ++n) _Pragma("unroll") for (int k = 0; k < 2; ++k) \
        acc[ai][bj][m][n] = __builtin_amdgcn_mfma_f32_16x16x32_bf16(Bt[n][k], At[m][k], acc[ai][bj][m][n], 0, 0, 0); __builtin_amdgcn_s_setprio(0); } while (0)
#define G8_WV(n) asm volatile("s_waitcnt vmcnt(" #n ")" ::: "memory")
#define G8_WL(n) asm volatile("s_waitcnt lgkmcnt(" #n ")" ::: "memory")
#define G8_BAR __builtin_amdgcn_s_barrier()
#define G8_SCHED __builtin_amdgcn_sched_barrier(0)
    f32x4 acc[2][2][4][2];
#pragma unroll
    for (int a = 0; a < 2; ++a)
#pragma unroll
        for (int b = 0; b < 2; ++b)
#pragma unroll
            for (int m = 0; m < 4; ++m)
#pragma unroll
                for (int n = 0; n < 2; ++n) acc[a][b][m][n] = (f32x4){0.f, 0.f, 0.f, 0.f};
    bf16x8 At[4][2], B0[2][2], B1[2][2];
    G8_STAGE(G8_SB(0, 0), Bb, voB[0], 0); G8_STAGE(G8_SA(0, 0), Ab, voA[0], 0); G8_STAGE(G8_SB(0, 1), Bb, voB[1], 0); G8_STAGE(G8_SA(0, 1), Ab, voA[1], 0);
    if (wr == 1) G8_BAR;
    G8_WV(4); G8_BAR;
    G8_STAGE(G8_SB(1, 0), Bb, voB[0], 1); G8_STAGE(G8_SA(1, 0), Ab, voA[0], 1); G8_STAGE(G8_SB(1, 1), Bb, voB[1], 1);
    G8_WV(6); G8_BAR;
    for (int t = 0; t < nt - 2; t += 2) {
        G8_LDB(B0, 0, 0); G8_SCHED; G8_LDA(At, 0, 0); G8_STAGE(G8_SA(1, 1), Ab, voA[1], t + 1);
        G8_WL(8); G8_BAR; G8_WL(0); G8_MMA(0, 0, At, B0); G8_BAR; G8_SCHED;
        G8_LDB(B1, 0, 1); G8_STAGE(G8_SB(0, 0), Bb, voB[0], t + 2);
        G8_BAR; G8_WL(0); G8_MMA(0, 1, At, B1); G8_BAR;
        G8_LDA(At, 0, 1); G8_STAGE(G8_SA(0, 0), Ab, voA[0], t + 2);
        G8_BAR; G8_WL(0); G8_MMA(1, 0, At, B0); G8_BAR; G8_SCHED;
        G8_STAGE(G8_SB(0, 1), Bb, voB[1], t + 2);
        G8_WV(6); G8_BAR; G8_MMA(1, 1, At, B1); G8_BAR;
        G8_LDB(B0, 1, 0); G8_SCHED; G8_LDA(At, 1, 0); G8_STAGE(G8_SA(0, 1), Ab, voA[1], t + 2);
        G8_WL(8); G8_BAR; G8_WL(0); G8_MMA(0, 0, At, B0); G8_BAR; G8_SCHED;
        G8_LDB(B1, 1, 1); G8_STAGE(G8_SB(1, 0), Bb, voB[0], t + 3);
        G8_BAR; G8_WL(0); G8_MMA(0, 1, At, B1); G8_BAR;
        G8_LDA(At, 1, 1); G8_STAGE(G8_SA(1, 0), Ab, voA[0], t + 3);
        G8_BAR; G8_WL(0); G8_MMA(1, 0, At, B0); G8_BAR; G8_SCHED;
        G8_STAGE(G8_SB(1, 1), Bb, voB[1], t + 3);
        G8_WV(6); G8_BAR; G8_MMA(1, 1, At, B1); G8_BAR;
    }
    { G8_LDB(B0, 0, 0); G8_LDA(At, 0, 0); G8_STAGE(G8_SA(1, 1), Ab, voA[1], nt - 1);
      G8_BAR; G8_WL(0); G8_MMA(0, 0, At, B0); G8_BAR;
      G8_LDB(B1, 0, 1); G8_BAR; G8_WL(0); G8_MMA(0, 1, At, B1); G8_BAR;
      G8_LDA(At, 0, 1); G8_WV(4); G8_BAR; G8_WL(0); G8_MMA(1, 0, At, B0); G8_MMA(1, 1, At, B1); G8_BAR; }
    { G8_LDB(B0, 1, 0); G8_LDA(At, 1, 0); G8_WV(2); G8_BAR; G8_WL(0); G8_MMA(0, 0, At, B0); G8_BAR;
      G8_LDB(B1, 1, 1); G8_WV(0); G8_BAR; G8_WL(0); G8_MMA(0, 1, At, B1); G8_BAR;
      G8_LDA(At, 1, 1); G8_BAR; G8_WL(0); G8_MMA(1, 0, At, B0); G8_MMA(1, 1, At, B1); G8_BAR; }
    if (wr == 0) G8_BAR;
    epi(acc, wr, wc, fr, fq);
    G8_WV(0);
#undef G8_SA
#undef G8_SB
#undef G8_STAGE
#undef G8_LDA
#undef G8_LDB
#undef G8_MMA
#undef G8_WV
#undef G8_WL
#undef G8_BAR
#undef G8_SCHED
}
__device__ __forceinline__ void my_stage_rc(int tid, int (&R)[2], int (&C)[2]) {
#pragma unroll
    for (int i = 0; i < 2; ++i) stage_rc(tid * 16 + i * 8192, R[i], C[i]);
}
}

__device__ __forceinline__ void ph_gemm_in(int wv, int layer, LAS unsigned char* lds) {
    const Params p = load_params();
    int wv_ = __builtin_amdgcn_readfirstlane(wv); asm volatile("" : "+s"(wv_)); int tid_; { int l_; asm volatile("v_mbcnt_lo_u32_b32 %0, -1, 0\n\tv_mbcnt_hi_u32_b32 %0, -1, %0" : "=v"(l_)); tid_ = wv_ * 64 + l_; } int bid_ = blockIdx.x; asm volatile("" : "+s"(bid_)); int nblk_ = gridDim.x; asm volatile("" : "+s"(nblk_));
    int R[2], C[2]; g8::my_stage_rc(tid_, R, C);
    const char* Ab = (const char*)(p.ws + OFF_XA);
    const char* Bb = (const char*)((const bf16_t*)(p.ws + OFF_WTIN) + (size_t)layer * NPC * DM);
    bf16_t* P = (bf16_t*)(p.ws + OFF_PB);
    constexpr int NM = NROW / 256, NN = NPC / 256;
    const int vb = (nblk_ % 8 == 0) ? (bid_ % 8) * (nblk_ / 8) + bid_ / 8 : bid_;
    for (int u = vb; u < NM * NN; u += nblk_) {
        const int pm = u / NN, pn = u % NN;
        unsigned voA[2][2], voB[2][2];
#pragma unroll
        for (int h = 0; h < 2; ++h)
#pragma unroll
            for (int i = 0; i < 2; ++i) { voA[h][i] = (unsigned)(((pm * 256 + h * 128 + R[i]) * DM + C[i]) * 2); voB[h][i] = (unsigned)(((pn * 256 + h * 128 + R[i]) * DM + C[i]) * 2); }
        g8::gemm_unit(tid_, lds, Ab, voA, Bb, voB, DM / 64, [&](const f32x4 (&acc)[2][2][4][2], int wr, int wc, int fr, int fq) {
#pragma unroll
            for (int ai = 0; ai < 2; ++ai)
#pragma unroll
                for (int m = 0; m < 4; ++m) {
                    const int row = pm * 256 + ai * 128 + wr * 64 + m * 16 + fr;
#pragma unroll
                    for (int bj = 0; bj < 2; ++bj)
#pragma unroll
                        for (int n = 0; n < 2; ++n) { const int col = pn * 256 + bj * 128 + wc * 32 + n * 16 + fq * 4; const f32x4 a = acc[ai][bj][m][n]; u32x2 o; o.x = pk_bf16(a.x, a.y); o.y = pk_bf16(a.z, a.w); *(u32x2*)(P + (size_t)row * NPC + col) = o; }
                }
        });
    }
}

__device__ __forceinline__ void ph_gemm_out(int wv, int layer, LAS unsigned char* lds) {
    const Params p = load_params();
    int wv_ = __builtin_amdgcn_readfirstlane(wv); asm volatile("" : "+s"(wv_)); int tid_; { int l_; asm volatile("v_mbcnt_lo_u32_b32 %0, -1, 0\n\tv_mbcnt_hi_u32_b32 %0, -1, %0" : "=v"(l_)); tid_ = wv_ * 64 + l_; } int bid_ = blockIdx.x; asm volatile("" : "+s"(bid_)); int nblk_ = gridDim.x; asm volatile("" : "+s"(nblk_));
    int R[2], C[2]; g8::my_stage_rc(tid_, R, C);
    const char* Ab = (const char*)(p.ws + OFF_Y);
    const char* Bb = (const char*)((const bf16_t*)(p.ws + OFF_WTOUT) + (size_t)layer * DM * DM);
    float* X1 = (float*)(p.ws + OFF_X1);
    const float* MODV = (const float*)(p.ws + OFF_MODV) + (size_t)layer * 3 * NMOD;
    const int NM = (layer == 0 ? NROW : NLAT) / 256, NN = DM / 256;
    const int vb = (nblk_ % 8 == 0) ? (bid_ % 8) * (nblk_ / 8) + bid_ / 8 : bid_;
    for (int u = vb; u < NM * NN; u += nblk_) {
        const int pm = u / NN, pn = u % NN;
        unsigned voA[2][2], voB[2][2];
#pragma unroll
        for (int h = 0; h < 2; ++h)
#pragma unroll
            for (int i = 0; i < 2; ++i) { voA[h][i] = (unsigned)(((pm * 256 + h * 128 + R[i]) * DM + C[i]) * 2); voB[h][i] = (unsigned)(((pn * 256 + h * 128 + R[i]) * DM + C[i]) * 2); }
        const float* g1 = MODV + (size_t)row_sel(pm * 256) * NMOD + 2 * DM;
        g8::gemm_unit(tid_, lds, Ab, voA, Bb, voB, DM / 64, [&](const f32x4 (&acc)[2][2][4][2], int wr, int wc, int fr, int fq) {
#pragma unroll
            for (int ai = 0; ai < 2; ++ai)
#pragma unroll
                for (int m = 0; m < 4; ++m) {
                    const int row = pm * 256 + ai * 128 + wr * 64 + m * 16 + fr;
                    const float* xr = xin_row(p, layer, row);
#pragma unroll
                    for (int bj = 0; bj < 2; ++bj)
#pragma unroll
                        for (int n = 0; n < 2; ++n) {
                            const int col = pn * 256 + bj * 128 + wc * 32 + n * 16 + fq * 4;
                            const f32x4 xv = *(const f32x4*)(xr + col), gv = *(const f32x4*)(g1 + col);
                            *(f32x4*)(X1 + (size_t)row * DM + col) = xv + gv * acc[ai][bj][m][n];
                        }
                }
        });
    }
}

__device__ __forceinline__ void ph_moe1(int wv, int layer, LAS unsigned char* lds) {
    const Params p = load_params();
    int wv_ = __builtin_amdgcn_readfirstlane(wv); asm volatile("" : "+s"(wv_)); int tid_; { int l_; asm volatile("v_mbcnt_lo_u32_b32 %0, -1, 0\n\tv_mbcnt_hi_u32_b32 %0, -1, %0" : "=v"(l_)); tid_ = wv_ * 64 + l_; } int bid_ = blockIdx.x; asm volatile("" : "+s"(bid_)); int nblk_ = gridDim.x; asm volatile("" : "+s"(nblk_));
    int R[2], C[2]; g8::my_stage_rc(tid_, R, C);
    const char* Ab = (const char*)(p.ws + OFF_XA);
    const int* IDX = (const int*)(p.ws + OFF_IDX);
    bf16_t* HID = (bf16_t*)(p.ws + OFF_HID);
    const int nunits = (layer == 0 ? NE * 9 : NE * 8) * 16;
    const int vb = (nblk_ % 8 == 0) ? (bid_ % 8) * (nblk_ / 8) + bid_ / 8 : bid_;
    for (int u = vb; u < nunits; u += nblk_) {
        int e, hr0, nvalid, nt;
        if (u < NE * 8 * 16) { e = u / 128; const int rem = u % 128, mt = rem % 8; nt = rem / 8; hr0 = e * 2048 + mt * 256; nvalid = 256; }
        else { const int v = u - NE * 8 * 16; e = v / 16; nt = v % 16; hr0 = NB * NE * CAPL + e * 64; nvalid = 64; }
        const char* Bb = (const char*)((const bf16_t*)(p.ws + OFF_WT13) + ((size_t)layer * NE + e) * 4096 * DM);
        unsigned voA[2][2], voB[2][2];
#pragma unroll
        for (int h = 0; h < 2; ++h)
#pragma unroll
            for (int i = 0; i < 2; ++i) {
                const int tr = (h * 128 + R[i]) & (nvalid - 1);
                const int rowid = IDX[hr0 + tr];
                voA[h][i] = (unsigned)((rowid * DM + C[i]) * 2);
                voB[h][i] = (unsigned)(((nt * 256 + h * 128 + R[i]) * DM + C[i]) * 2);
            }
        g8::gemm_unit(tid_, lds, Ab, voA, Bb, voB, DM / 64, [&](const f32x4 (&acc)[2][2][4][2], int wr, int wc, int fr, int fq) {
#pragma unroll
            for (int ai = 0; ai < 2; ++ai)
#pragma unroll
                for (int m = 0; m < 4; ++m) {
                    const int tr = ai * 128 + wr * 64 + m * 16 + fr;
                    if (tr < nvalid) {
#pragma unroll
                        for (int n = 0; n < 2; ++n) {
                            const int f = nt * 128 + wc * 32 + n * 16 + fq * 4;
                            const f32x4 a = acc[ai][0][m][n], b = acc[ai][1][m][n];
                            u32x2 o; o.x = pk_bf16(fsilu(a.x) * b.x, fsilu(a.y) * b.y); o.y = pk_bf16(fsilu(a.z) * b.z, fsilu(a.w) * b.w);
                            *(u32x2*)(HID + (size_t)(hr0 + tr) * FF + f) = o;
                        }
                    }
                }
        });
    }
}
__device__ __forceinline__ void ph_moe2(int wv, int layer, LAS unsigned char* lds) {
    const Params p = load_params();
    int wv_ = __builtin_amdgcn_readfirstlane(wv); asm volatile("" : "+s"(wv_)); int tid_; { int l_; asm volatile("v_mbcnt_lo_u32_b32 %0, -1, 0\n\tv_mbcnt_hi_u32_b32 %0, -1, %0" : "=v"(l_)); tid_ = wv_ * 64 + l_; } int bid_ = blockIdx.x; asm volatile("" : "+s"(bid_)); int nblk_ = gridDim.x; asm volatile("" : "+s"(nblk_));
    int R[2], C[2]; g8::my_stage_rc(tid_, R, C);
    const char* Ab = (const char*)(p.ws + OFF_HID);
    const float* VALS = (const float*)(p.ws + OFF_VALS);
    bf16_t* YE = (bf16_t*)(p.ws + OFF_YE);
    const int nunits = NE * 8 * 4 + (layer == 0 ? NE * 4 * 4 : 0);
    const int vb = (nblk_ % 8 == 0) ? (bid_ % 8) * (nblk_ / 8) + bid_ / 8 : bid_;
    for (int u = vb; u < nunits; u += nblk_) {
        int e, hr0, nvalid, nt, kq = 0, nkt = FF / 64;
        bf16_t* yout;
        if (u < NE * 8 * 4) { e = u / 32; const int rem = u % 32, mt = rem % 8; nt = rem / 8; hr0 = e * 2048 + mt * 256; nvalid = 256; yout = YE + (size_t)hr0 * DM; }
        else { const int v = u - NE * 8 * 4; e = v >> 4; nt = (v >> 2) & 3; kq = v & 3; hr0 = NB * NE * CAPL + e * 64; nvalid = 64; nkt = FF / 64 / 4; yout = (bf16_t*)(p.ws + OFF_YEC) + (size_t)(kq * 1024 + e * 64) * DM; }
        const char* Bb = (const char*)((const bf16_t*)(p.ws + OFF_WT2) + ((size_t)layer * NE + e) * DM * FF);
        unsigned voA[2][2], voB[2][2];
#pragma unroll
        for (int h = 0; h < 2; ++h)
#pragma unroll
            for (int i = 0; i < 2; ++i) {
                const int tr = (h * 128 + R[i]) & (nvalid - 1);
                voA[h][i] = (unsigned)(((size_t)(hr0 + tr) * FF + C[i] + kq * 512) * 2);
                voB[h][i] = (unsigned)(((nt * 256 + h * 128 + R[i]) * FF + C[i] + kq * 512) * 2);
            }
        g8::gemm_unit(tid_, lds, Ab, voA, Bb, voB, nkt, [&](const f32x4 (&acc)[2][2][4][2], int wr, int wc, int fr, int fq) {
#pragma unroll
            for (int ai = 0; ai < 2; ++ai)
#pragma unroll
                for (int m = 0; m < 4; ++m) {
                    const int tr = ai * 128 + wr * 64 + m * 16 + fr;
                    if (tr < nvalid) {
                        const float vv = VALS[hr0 + tr];
#pragma unroll
                        for (int bj = 0; bj < 2; ++bj)
#pragma unroll
                            for (int n = 0; n < 2; ++n) { const int col = nt * 256 + bj * 128 + wc * 32 + n * 16 + fq * 4; const f32x4 yv = acc[ai][bj][m][n] * vv; u32x2 o; o.x = pk_bf16(yv.x, yv.y); o.y = pk_bf16(yv.z, yv.w); *(u32x2*)(yout + (size_t)tr * DM + col) = o; }
                    }
                }
        });
    }
}

__device__ __forceinline__ void unpack8(const u32x4 w, float (&f)[8]) {
    f[0] = __uint_as_float(w.x << 16); f[1] = __uint_as_float(w.x & 0xffff0000u); f[2] = __uint_as_float(w.y << 16); f[3] = __uint_as_float(w.y & 0xffff0000u);
    f[4] = __uint_as_float(w.z << 16); f[5] = __uint_as_float(w.z & 0xffff0000u); f[6] = __uint_as_float(w.w << 16); f[7] = __uint_as_float(w.w & 0xffff0000u);
}
__device__ __forceinline__ u32x4 pack8(const float (&f)[8]) { u32x4 o; o.x = pk_bf16(f[0], f[1]); o.y = pk_bf16(f[2], f[3]); o.z = pk_bf16(f[4], f[5]); o.w = pk_bf16(f[6], f[7]); return o; }
__device__ __forceinline__ float sum8lanes(float v) { v += xor_lane<1>(v); v += xor_lane<2>(v); v += xor_lane<4>(v); return v; }
__device__ __forceinline__ void ph_prep(int wv, int layer) {
    const Params p = load_params();
    PHASE_IDS();
    const int tid = tid_, lane = tid & 63, wave = tid >> 6;
    const int gw = bid_ * 8 + wave, NGW = nblk_ * 8;
    const GAS bf16_t* P = (const GAS bf16_t*)(p.ws + OFF_PB);
    GAS bf16_t* QB = (GAS bf16_t*)(p.ws + OFF_QB); GAS bf16_t* KB = (GAS bf16_t*)(p.ws + OFF_KB); GAS bf16_t* VN = (GAS bf16_t*)(p.ws + OFF_VT);
    GAS bf16_t* GQ = (GAS bf16_t*)(p.ws + OFF_GQB); GAS bf16_t* GK = (GAS bf16_t*)(p.ws + OFF_GKB); GAS bf16_t* GV = (GAS bf16_t*)(p.ws + OFF_GVB);
    const float* RT = (const float*)(p.ws + OFF_ROPE);
    const int i8 = lane & 7, d0 = 8 * i8;
    const int axis = i8 >> 2, half = (i8 >> 1) & 1, f0 = 8 * (i8 & 1);
    float qg[8], kg[8];
#pragma unroll
    for (int j = 0; j < 8; ++j) { qg[j] = p.in[I_QNG][layer * 64 + d0 + j]; kg[j] = p.in[I_KNG][layer * 64 + d0 + j]; }
    const float* cw = p.in[I_GCW] + (size_t)layer * 5 * 768;
    f32x4 cwa[2][5][2];
#pragma unroll
    for (int pass = 0; pass < 2; ++pass)
#pragma unroll
        for (int t = 0; t < 5; ++t) {
            const int ch0 = (pass == 1 && lane >= 32) ? 0 : pass * 512 + 8 * lane;
            cwa[pass][t][0] = *(const f32x4*)(cw + t * 768 + ch0); cwa[pass][t][1] = *(const f32x4*)(cw + t * 768 + ch0 + 4);
        }
    for (int r = gw; r < NROW; r += NGW) {
        const bool lat = r < NLAT;
        const int b = lat ? (r >> 13) : ((r - NLAT) >> 8);
        const int n = lat ? (r & (SEQ - 1)) : ((r - NLAT) & (CTXL - 1));
        const GAS bf16_t* pr = P + (size_t)r * NPC;
        float cs[8], sn[8];
        if (lat) {
            const int pos = axis == 0 ? (n >> 6) : (n & 63);
            const f32x4 c0 = *(const f32x4*)(RT + pos * 16 + f0), c1 = *(const f32x4*)(RT + pos * 16 + f0 + 4), s0 = *(const f32x4*)(RT + 2048 + pos * 16 + f0), s1 = *(const f32x4*)(RT + 2048 + pos * 16 + f0 + 4);
#pragma unroll
            for (int j = 0; j < 4; ++j) { cs[j] = c0[j]; cs[4 + j] = c1[j]; sn[j] = s0[j]; sn[4 + j] = s1[j]; }
        } else {
#pragma unroll
            for (int j = 0; j < 8; ++j) { cs[j] = 1.f; sn[j] = 0.f; }
        }
        const int kpos = lat ? CTXL + n : n;
        const int slen = lat ? SEQ : CTXL;
        const u32x4 qraw = *(const GAS u32x4*)(pr + 8 * lane);
        u32x4 kvraw = {0u, 0u, 0u, 0u};
        if (lane < 32) kvraw = *(const GAS u32x4*)(pr + 512 + 8 * lane);
        u32x4 tp0[5], tp1[5]; float tm[5];
#pragma unroll
        for (int t = 0; t < 5; ++t) {
            const int nn = n + t - 2;
            const bool ok = nn >= 0 && nn < slen;
            const GAS bf16_t* tr = P + (size_t)(ok ? r + t - 2 : r) * NPC + 1792 + 8 * lane;
            tm[t] = ok ? 1.f : 0.f;
            tp0[t] = *(const GAS u32x4*)tr;
            tp1[t] = (u32x4){0u, 0u, 0u, 0u};
            if (lane < 32) tp1[t] = *(const GAS u32x4*)(tr + 512);
        }
        {
            float v[8]; unpack8(qraw, v);
            float ss = 0.f;
#pragma unroll
            for (int j = 0; j < 8; ++j) ss += v[j] * v[j];
            const float rstd = rsqrtf(sum8lanes(ss) * (1.f / 64.f) + EPS);
            float o[8];
#pragma unroll
            for (int j = 0; j < 8; ++j) { const float y = v[j] * rstd * qg[j]; const float pv = xor_lane<2>(y); o[j] = (half == 0 ? y * cs[j] - pv * sn[j] : y * cs[j] + pv * sn[j]) * QSCALE; }
            *(GAS u32x4*)(QB + (size_t)r * 512 + 8 * lane) = pack8(o);
        }
        if (lane < 32) {
            const u32x4 raw = kvraw;
            float v[8]; unpack8(raw, v);
            float ss = 0.f;
#pragma unroll
            for (int j = 0; j < 8; ++j) ss += v[j] * v[j];
            const float rstd = rsqrtf(sum8lanes(ss) * (1.f / 64.f) + EPS);
            float o[8];
#pragma unroll
            for (int j = 0; j < 8; ++j) { const float y = v[j] * rstd * kg[j]; const float pv = xor_lane<2>(y); o[j] = half == 0 ? y * cs[j] - pv * sn[j] : y * cs[j] + pv * sn[j]; }
            const int g = (lane >> 3) & 1;
            if (lane < 16) *(GAS u32x4*)(KB + ((size_t)(b * 2 + g) * KPOS + kpos) * 64 + d0) = pack8(o);
            else *(GAS u32x4*)(VN + ((size_t)(b * 2 + g) * KPOS + kpos) * 64 + d0) = raw;
        }
#pragma unroll
        for (int pass = 0; pass < 2; ++pass) {
            if (pass == 1 && lane >= 32) break;
            const int ch0 = pass * 512 + 8 * lane;
            float a[8];
#pragma unroll
            for (int j = 0; j < 8; ++j) a[j] = 0.f;
#pragma unroll
            for (int t = 0; t < 5; ++t) {
                {
                    float v[8]; unpack8(pass == 0 ? tp0[t] : tp1[t], v);
                    const f32x4 w0 = cwa[pass][t][0] * tm[t], w1 = cwa[pass][t][1] * tm[t];
#pragma unroll
                    for (int j = 0; j < 4; ++j) { a[j] += v[j] * w0[j]; a[4 + j] += v[4 + j] * w1[j]; }
                }
            }
            float ss = 0.f;
#pragma unroll
            for (int j = 0; j < 8; ++j) { a[j] = fsilu(a[j]); ss += a[j] * a[j]; }
            if (pass == 0) {
                const float sc = rsqrtf(sum8lanes(ss) + EPS) * (lane < 32 ? 0.125f : 1.f);
#pragma unroll
                for (int j = 0; j < 8; ++j) a[j] *= sc;
                if (lane < 32) *(GAS u32x4*)(GQ + (size_t)r * 256 + 8 * lane) = pack8(a);
                else *(GAS u32x4*)(GK + (size_t)r * 256 + 8 * (lane - 32)) = pack8(a);
            } else *(GAS u32x4*)(GV + (size_t)r * 256 + 8 * lane) = pack8(a);
        }
    }
}

template <int U> __device__ __forceinline__ bf16x8 acc_frag(const f32x16& a);
__device__ __forceinline__ bf16x8 mk_frag(u32x2 lo, u32x2 hi8);
__device__ __forceinline__ void vt_store(LAS unsigned char* vt, int key, int dch, u32x4 v) {
    LAS unsigned short* b = (LAS unsigned short*)(vt + (8 * dch) * 136 + key * 2);
    b[0 * 68] = (unsigned short)v.x; b[1 * 68] = (unsigned short)(v.x >> 16); b[2 * 68] = (unsigned short)v.y; b[3 * 68] = (unsigned short)(v.y >> 16);
    b[4 * 68] = (unsigned short)v.z; b[5 * 68] = (unsigned short)(v.z >> 16); b[6 * 68] = (unsigned short)v.w; b[7 * 68] = (unsigned short)(v.w >> 16);
}
namespace attn_body {
using bf16=__hip_bfloat16;
using bf16x8=__attribute__((ext_vector_type(8)))short;
using s16x4=__attribute__((ext_vector_type(4)))short;
using f32x16=__attribute__((ext_vector_type(16)))float;
using u32x4=__attribute__((ext_vector_type(4)))unsigned;
constexpr int D=64, QP=512, KVP=64, OP=1024;
constexpr int NW=8,QBLK=32,QB=QBLK*NW,KVBLK=64;
__device__ __forceinline__ int crow(int r,int hi){return (r&3)+8*(r>>2)+4*hi;}
#define SBAR() __builtin_amdgcn_sched_barrier(0)
constexpr int NSLOT=3, SLOTB=8192;
constexpr int LDS_K=0, LDS_V=NSLOT*SLOTB, LDS_WS=2*NSLOT*SLOTB, LDS_OST=LDS_WS+NW*64*4, LDS_BYTES=LDS_OST+NW*4096;
constexpr float C2=0.125f*1.4426950408889634f;
__device__ __forceinline__ void glds16(const void*gsrc,unsigned lds_dst){unsigned keep;
  asm volatile("s_mov_b32 %0, m0\n\ts_mov_b32 m0, %2\n\ts_nop 0\n\tglobal_load_lds_dwordx4 %1, off\n\ts_mov_b32 m0, %0":"=&s"(keep):"v"(gsrc),"s"(lds_dst):"memory");}
__device__ __forceinline__ float max3f(float a,float b,float c){float r;asm("v_max3_f32 %0, %1, %2, %3":"=v"(r):"v"(a),"v"(b),"v"(c));return r;}
__device__ __forceinline__ float max2f(float a,float b){float r;asm("v_max_f32_e32 %0, %1, %2":"=v"(r):"v"(a),"v"(b));return r;}
__device__ __forceinline__ float fadd_s(float a,float b){float r;asm("v_add_f32_e32 %0, %1, %2":"=v"(r):"v"(a),"v"(b));return r;}
__device__ __forceinline__ float fsub_s(float a,float b){float r;asm("v_sub_f32_e32 %0, %1, %2":"=v"(r):"v"(a),"v"(b));return r;}
typedef float f32x2_t __attribute__((ext_vector_type(2))); typedef __bf16 bf16x2_t __attribute__((ext_vector_type(2)));
__device__ __forceinline__ unsigned cvtpk_s(float lo,float hi){f32x2_t v={lo,hi};bf16x2_t b=__builtin_convertvector(v,bf16x2_t);return __builtin_bit_cast(unsigned,b);}
#define WAIT_BAR(N) asm volatile("s_waitcnt vmcnt(" #N ") lgkmcnt(0)\n\ts_barrier":::"memory")

__device__ __forceinline__ void qkt(f32x16&p0,f32x16&p1,const char*Kslot,const bf16x8*qr,const f32x16&negm,int r32,int hi){
  const char*kb=Kslot+hi*1024+r32*16;
  #pragma unroll
  for(int d0=0;d0<4;++d0){
    const bf16x8 b0=*reinterpret_cast<const bf16x8*>(kb+d0*2048);
    const bf16x8 b1=*reinterpret_cast<const bf16x8*>(kb+d0*2048+512);
    if(d0==0){p0=__builtin_amdgcn_mfma_f32_32x32x16_bf16(b0,qr[0],negm,0,0,0);p1=__builtin_amdgcn_mfma_f32_32x32x16_bf16(b1,qr[0],negm,0,0,0);}
    else{p0=__builtin_amdgcn_mfma_f32_32x32x16_bf16(b0,qr[d0],p0,0,0,0);p1=__builtin_amdgcn_mfma_f32_32x32x16_bf16(b1,qr[d0],p1,0,0,0);}}
}
typedef __attribute__((address_space(3))) const char* lds_cptr;
typedef short v4i16_t __attribute__((ext_vector_type(4)));
__device__ __forceinline__ void kload8(bf16x8*kf,lds_cptr kp){
  kf[0]=*(const __attribute__((address_space(3))) bf16x8*)(kp);      kf[1]=*(const __attribute__((address_space(3))) bf16x8*)(kp+512);
  kf[2]=*(const __attribute__((address_space(3))) bf16x8*)(kp+2048); kf[3]=*(const __attribute__((address_space(3))) bf16x8*)(kp+2560);
  kf[4]=*(const __attribute__((address_space(3))) bf16x8*)(kp+4096); kf[5]=*(const __attribute__((address_space(3))) bf16x8*)(kp+4608);
  kf[6]=*(const __attribute__((address_space(3))) bf16x8*)(kp+6144); kf[7]=*(const __attribute__((address_space(3))) bf16x8*)(kp+6656);
}
__device__ __forceinline__ void kload2(bf16x8*kf,lds_cptr kp,int j){ kf[2*j]=*(const __attribute__((address_space(3))) bf16x8*)(kp+j*2048); kf[2*j+1]=*(const __attribute__((address_space(3))) bf16x8*)(kp+j*2048+512); }
__device__ __forceinline__ s16x4 vtr(lds_cptr p){ return __builtin_bit_cast(s16x4,__builtin_amdgcn_ds_read_tr16_b64_v4i16((__attribute__((address_space(3))) v4i16_t*)p)); }
__device__ __forceinline__ float rowmax(const f32x16&p0,const f32x16&p1){
  float a=max3f(p0[0],p0[1],p1[0]),b=max3f(p0[2],p0[3],p1[1]);a=max3f(a,p1[2],p1[3]);
  #pragma unroll
  for(int r=4;r<16;r+=4){a=max3f(a,p0[r],p0[r+1]);b=max3f(b,p0[r+2],p0[r+3]);a=max3f(a,p1[r],p1[r+1]);b=max3f(b,p1[r+2],p1[r+3]);}
  const float m=max2f(a,b);
  auto rr=__builtin_amdgcn_permlane32_swap(__float_as_uint(m),__float_as_uint(m),false,false);
  return max2f(__uint_as_float(rr[0]),__uint_as_float(rr[1]));
}
__device__ __forceinline__ void pv(f32x16*o,int vb,bf16x8 pa0,bf16x8 pa1,bf16x8 pa2,bf16x8 pa3){
  #pragma unroll
  for(int d0=0;d0<2;++d0){s16x4 lo[4],hi[4];
    #pragma unroll
    for(int ks=0;ks<4;++ks){
      asm volatile("ds_read_b64_tr_b16 %0,%1 offset:%c2":"=&v"(lo[ks]):"v"(vb),"i"(d0*4096+ks*1024):"memory");
      asm volatile("ds_read_b64_tr_b16 %0,%1 offset:%c2":"=&v"(hi[ks]):"v"(vb),"i"(d0*4096+ks*1024+512):"memory");}
    asm volatile("s_waitcnt lgkmcnt(0)":::"memory");SBAR();
    #define PK(k) (bf16x8){lo[k][0],lo[k][1],lo[k][2],lo[k][3],hi[k][0],hi[k][1],hi[k][2],hi[k][3]}
    o[d0]=__builtin_amdgcn_mfma_f32_32x32x16_bf16(pa0,PK(0),o[d0],0,0,0);
    o[d0]=__builtin_amdgcn_mfma_f32_32x32x16_bf16(pa1,PK(1),o[d0],0,0,0);
    o[d0]=__builtin_amdgcn_mfma_f32_32x32x16_bf16(pa2,PK(2),o[d0],0,0,0);
    o[d0]=__builtin_amdgcn_mfma_f32_32x32x16_bf16(pa3,PK(3),o[d0],0,0,0);
    #undef PK
  }
}

#ifndef ATTN_STORE16
#define ATTN_STORE16(p,v) (*(u32x4*)(p)=(v))
#endif
template<int THRL> __device__ __forceinline__ void attn_unit(const int tid,const int NT,const bf16*Qw0,const bf16*__restrict__ Kh,const bf16*__restrict__ Vh,bf16*Ow0,char*shm,float*ML=nullptr){
  const int lane=tid&63,r32=lane&31,hi=lane>>5; const int wid=__builtin_amdgcn_readfirstlane(tid>>6);
  const bf16*Qw=Qw0+(long)(wid*QBLK)*QP;
  const unsigned lds0=(unsigned)(uintptr_t)shm;
  float*wsf=(float*)(shm+LDS_WS)+wid*64;
  const bf16*ksrc=Kh+(long)lane*KVP+wid*8;
  const bf16*vsrc=Vh+(long)(16*(wid&3)+(lane>>2))*KVP+(wid>>2)*32+(lane&3)*8;
  const unsigned kdst=lds0+LDS_K+wid*1024, vdst=lds0+LDS_V+wid*1024;
  #define DMA_K(t,slot) glds16(ksrc+(long)(t)*KVBLK*KVP,(unsigned)__builtin_amdgcn_readfirstlane(kdst+(slot)))
  #define DMA_V(t,slot) glds16(vsrc+(long)(t)*KVBLK*KVP,(unsigned)__builtin_amdgcn_readfirstlane(vdst+(slot)))
  const int vb0=(int)(lds0+LDS_V)+((lane>>4)&1)*32+(lane&3)*8+(4*hi+((lane&15)>>2))*64;
  const char*Kbase=shm+LDS_K; bf16x8 kf[8];
  const lds_cptr shm3=(lds_cptr)shm; const lds_cptr kp0=shm3+LDS_K+hi*1024+r32*16; const lds_cptr vp0=shm3+LDS_V+((lane>>4)&1)*32+(lane&3)*8+(4*hi+((lane&15)>>2))*64;
  DMA_K(0,0);DMA_V(0,0);DMA_K(1,SLOTB);
  bf16x8 qr[4];
  #pragma unroll
  for(int d0=0;d0<4;++d0)qr[d0]=*reinterpret_cast<const bf16x8*>(&Qw[(long)r32*QP+d0*16+hi*8]);
  float mhat=0.f,l_reg=0.f;f32x16 o[2];o[0]=f32x16{};o[1]=f32x16{};f32x16 negm=f32x16{};asm volatile("":"+v"(negm));
  #define CMASK(P0,P1,t) do{}while(0)
  bool resc=false;
  #define START(P0,P1) do{ const float rm=rowmax(P0,P1); resc=false; \
    { const float dl=rm; mhat=fadd_s(mhat,dl); \
      _Pragma("unroll") for(int r=0;r<16;++r){P0[r]=fsub_s(P0[r],dl);P1[r]=fsub_s(P1[r],dl);} \
      _Pragma("unroll") for(int r=0;r<16;++r)negm[r]=-mhat; asm volatile("":"+v"(negm)); } \
    _Pragma("unroll") for(int r=0;r<16;++r)P0[r]=__builtin_amdgcn_exp2f(P0[r]); }while(0)
  #define RESC() do{ if(resc){ asm volatile("s_waitcnt lgkmcnt(0)":::"memory"); \
      _Pragma("unroll") for(int d_=0;d_<2;++d_) _Pragma("unroll") for(int r=0;r<16;++r)o[d_][r]*=wsf[crow(r,hi)]; } }while(0)
  f32x16 pA0,pA1,pB0,pB1;
  int sl_prev=0,sl_cur=0,sl_next=SLOTB;
  #define ROT() do{sl_prev=sl_cur;sl_cur=sl_next;sl_next=(sl_next==(NSLOT-1)*SLOTB)?0:sl_next+SLOTB;}while(0)
  DMA_K(2,2*SLOTB);
  WAIT_BAR(3);
  qkt(pA0,pA1,Kbase,qr,negm,r32,hi);asm volatile("s_nop 15\n\ts_nop 7":"+v"(pA0),"+v"(pA1));CMASK(pA0,pA1,0);
  START(pA0,pA1);
  _Pragma("unroll") for(int r=0;r<16;++r)pA1[r]=__builtin_amdgcn_exp2f(pA1[r]);
  WAIT_BAR(0);
  DMA_K(3,0);DMA_V(1,SLOTB);
  ROT();
  kload8(kf,kp0+sl_cur);
  WAIT_BAR(2);
  s16x4 vlo[8],vhi[8]; u32x4 pw0,pw1,pw2,pw3;
  #define PKW(P,B) cvtpk_s(P[B],P[B+1])
  #define PAF(k) __builtin_bit_cast(bf16x8,pw##k)
  #define VFR(i) (bf16x8){vlo[i][0],vlo[i][1],vlo[i][2],vlo[i][3],vhi[i][0],vhi[i][1],vhi[i][2],vhi[i][3]}
  #define PIN(x) asm volatile("":"+v"(x))
  #define MX3(a,b,c) __builtin_fmaxf(__builtin_fmaxf((a),(b)),(c))
  #define GAPA(MF,A0,A1,A2,A3,W0,W1,PW) do{ MF; sacc+=A0; sacc+=A1; sacc+=A2; sacc+=A3; PIN(sacc); W0; W1; PIN(PW); SBAR(); }while(0)
  #define EX(v) __builtin_amdgcn_exp2f(v)
  #define GAPB(MF,X,B) do{ MF; X[B]=EX(X[B]); X[B+1]=EX(X[B+1]); X[B+2]=EX(X[B+2]); X[B+3]=EX(X[B+3]); PIN(X); SBAR(); }while(0)
  #define VRD(i) do{ vlo[i]=vtr(vp_+(((i)>>2)*4096+((i)&3)*1024)); vhi[i]=vtr(vp_+(((i)>>2)*4096+((i)&3)*1024+512)); }while(0)
  #define KRD(G,j) do{ if(G){ kload2(kf,kp0+sl_next,j); SBAR(); } }while(0)
  #define STEP(C0,C1,P0,P1,t,GK,GV,GL) do{ SBAR(); \
    const lds_cptr vp_=vp0+sl_prev; \
    VRD(0); SBAR(); float sacc=(P0[0]+P0[1]); \
    GAPA(C0=__builtin_amdgcn_mfma_f32_32x32x16_bf16(kf[0],qr[0],negm,0,0,0), P0[2],P0[3],P0[4],P0[5],     pw0[0]=PKW(P0,0), pw0[1]=PKW(P0,2), pw0); \
    VRD(4); SBAR(); GAPA(C1=__builtin_amdgcn_mfma_f32_32x32x16_bf16(kf[1],qr[0],negm,0,0,0), P0[6],P0[7],P0[8],P0[9],     pw0[2]=PKW(P0,4), pw0[3]=PKW(P0,6), pw0); \
    VRD(1); SBAR(); GAPA(C0=__builtin_amdgcn_mfma_f32_32x32x16_bf16(kf[2],qr[1],C0,0,0,0),   P0[10],P0[11],P0[12],P0[13], pw1[0]=PKW(P0,8), pw1[1]=PKW(P0,10), pw1); \
    VRD(5); SBAR(); GAPA(C1=__builtin_amdgcn_mfma_f32_32x32x16_bf16(kf[3],qr[1],C1,0,0,0),   P0[14],P0[15],P1[0],P1[1],   pw1[2]=PKW(P0,12),pw1[3]=PKW(P0,14), pw1); \
    VRD(2); SBAR(); GAPA(C0=__builtin_amdgcn_mfma_f32_32x32x16_bf16(kf[4],qr[2],C0,0,0,0),   P1[2],P1[3],P1[4],P1[5],     pw2[0]=PKW(P1,0), pw2[1]=PKW(P1,2), pw2); \
    VRD(6); SBAR(); GAPA(C1=__builtin_amdgcn_mfma_f32_32x32x16_bf16(kf[5],qr[2],C1,0,0,0),   P1[6],P1[7],P1[8],P1[9],     pw2[2]=PKW(P1,4), pw2[3]=PKW(P1,6), pw2); \
    VRD(3); SBAR(); GAPA(C0=__builtin_amdgcn_mfma_f32_32x32x16_bf16(kf[6],qr[3],C0,0,0,0),   P1[10],P1[11],P1[12],P1[13], pw3[0]=PKW(P1,8), pw3[1]=PKW(P1,10), pw3); \
    VRD(7); SBAR(); GAPA(C1=__builtin_amdgcn_mfma_f32_32x32x16_bf16(kf[7],qr[3],C1,0,0,0),   P1[14],P1[15],0.f,0.f,       pw3[2]=PKW(P1,12),pw3[3]=PKW(P1,14), pw3); \
    l_reg+=sacc; \
    if(GK){DMA_K((t)+3,sl_cur);} if(GV){DMA_V((t)+1,sl_next);} \
    CMASK(C0,C1,t); \
    { float a=MX3(C0[0],C0[1],C1[0]),b=MX3(C0[2],C0[3],C1[1]); a=MX3(a,C1[2],C1[3]); \
      _Pragma("unroll") for(int r=4;r<16;r+=4){a=MX3(a,C0[r],C0[r+1]);b=MX3(b,C0[r+2],C0[r+3]);a=MX3(a,C1[r],C1[r+1]);b=MX3(b,C1[r+2],C1[r+3]);} \
      float rm=__builtin_fmaxf(a,b); { auto rr=__builtin_amdgcn_permlane32_swap(__float_as_uint(rm),__float_as_uint(rm),false,false); rm=__builtin_fmaxf(__uint_as_float(rr[0]),__uint_as_float(rr[1])); } \
      resc=false; \
      if(__builtin_expect(__any(rm>(float)THRL),0)){ const float dl=__builtin_fmaxf(rm,0.f); mhat+=dl; \
        _Pragma("unroll") for(int r=0;r<16;++r){C0[r]-=dl;C1[r]-=dl;} \
        _Pragma("unroll") for(int r=0;r<16;++r)negm[r]=-mhat; asm volatile("":"+v"(negm)); \
        const float f=__builtin_amdgcn_exp2f(-dl); l_reg*=f; if(hi==0)wsf[r32]=f; resc=true; } } \
    SBAR(); \
    GAPB(o[0]=__builtin_amdgcn_mfma_f32_32x32x16_bf16(PAF(0),VFR(0),o[0],0,0,0), C0,0); \
    GAPB(o[1]=__builtin_amdgcn_mfma_f32_32x32x16_bf16(PAF(0),VFR(4),o[1],0,0,0), C0,4); \
    KRD(GL,0); GAPB(o[0]=__builtin_amdgcn_mfma_f32_32x32x16_bf16(PAF(1),VFR(1),o[0],0,0,0), C0,8); \
    KRD(GL,1); GAPB(o[1]=__builtin_amdgcn_mfma_f32_32x32x16_bf16(PAF(1),VFR(5),o[1],0,0,0), C0,12); \
    KRD(GL,2); GAPB(o[0]=__builtin_amdgcn_mfma_f32_32x32x16_bf16(PAF(2),VFR(2),o[0],0,0,0), C1,0); \
    KRD(GL,3); GAPB(o[1]=__builtin_amdgcn_mfma_f32_32x32x16_bf16(PAF(2),VFR(6),o[1],0,0,0), C1,4); \
    GAPB(o[0]=__builtin_amdgcn_mfma_f32_32x32x16_bf16(PAF(3),VFR(3),o[0],0,0,0), C1,8); \
    GAPB(o[1]=__builtin_amdgcn_mfma_f32_32x32x16_bf16(PAF(3),VFR(7),o[1],0,0,0), C1,12); \
    }while(0)
  int t=1;
  #undef CMASK
  #define CMASK(P0,P1,t) do{}while(0)
  for(;t+5<NT;t+=2){
    STEP(pB0,pB1,pA0,pA1,t,true,true,true);     WAIT_BAR(2); RESC(); ROT();
    STEP(pA0,pA1,pB0,pB1,t+1,true,true,true);   WAIT_BAR(2); RESC(); ROT();
  }
  #undef CMASK
  #define CMASK(P0,P1,t) do{}while(0)
  #define ENDW(tt) do{ if((tt)+3<NT){WAIT_BAR(2);} else if((tt)+2<NT){WAIT_BAR(1);} else {WAIT_BAR(0);} }while(0)
  for(;t+1<NT;t+=2){
    STEP(pB0,pB1,pA0,pA1,t,(t+3<NT),(t+1<NT),(t+1<NT));       ENDW(t);   RESC(); ROT();
    STEP(pA0,pA1,pB0,pB1,t+1,(t+4<NT),(t+2<NT),(t+2<NT));     ENDW(t+1); RESC(); ROT();
  }
  STEP(pB0,pB1,pA0,pA1,NT-1,false,false,false); RESC();
  { float sacc=pB0[0]+pB0[1]; _Pragma("unroll") for(int r=2;r<16;++r)sacc+=pB0[r]; _Pragma("unroll") for(int r=0;r<16;++r)sacc+=pB1[r]; l_reg+=sacc;
    pw0=(u32x4){PKW(pB0,0),PKW(pB0,2),PKW(pB0,4),PKW(pB0,6)};pw1=(u32x4){PKW(pB0,8),PKW(pB0,10),PKW(pB0,12),PKW(pB0,14)};pw2=(u32x4){PKW(pB1,0),PKW(pB1,2),PKW(pB1,4),PKW(pB1,6)};pw3=(u32x4){PKW(pB1,8),PKW(pB1,10),PKW(pB1,12),PKW(pB1,14)};
    SBAR(); pv(o,vb0+sl_cur,PAF(0),PAF(1),PAF(2),PAF(3)); }
  #undef PKW
  #undef PAF
  #undef VFR
  #undef PIN
  #undef MX3
  #undef GAPA
  #undef GAPB
  #undef EX
  #undef VRD
  #undef KRD
  #undef STEP
  #undef ENDW
  {auto rr=__builtin_amdgcn_permlane32_swap(__float_as_uint(l_reg),__float_as_uint(l_reg),false,false);l_reg=__uint_as_float(rr[0])+__uint_as_float(rr[1]);}
  if(hi==0)wsf[32+r32]=l_reg;asm volatile("s_waitcnt lgkmcnt(0)":::"memory");
  if(ML!=nullptr&&hi==0){ML[2*(wid*QBLK+r32)]=mhat;ML[2*(wid*QBLK+r32)+1]=l_reg;}
  float rli[16];
  #pragma unroll
  for(int r=0;r<16;++r)rli[r]=__builtin_amdgcn_rcpf(wsf[32+crow(r,hi)]);
  bf16*Ow=Ow0+(long)(wid*QBLK)*OP;
  { bf16*stg=(bf16*)(shm+LDS_OST)+wid*2048;
    #pragma unroll
    for(int r=0;r<16;++r){const int orow=crow(r,hi);
      #pragma unroll
      for(int d0=0;d0<2;++d0)stg[orow*64+d0*32+r32]=__float2bfloat16(o[d0][r]*rli[r]);}
    asm volatile("s_waitcnt lgkmcnt(0)":::"memory");
    #pragma unroll
    for(int i=0;i<4;++i){const int row=i*8+(lane>>3),ch=lane&7; const u32x4 v=*(const u32x4*)(stg+row*64+ch*8); ATTN_STORE16(Ow+(long)row*OP+ch*8,v);} }
  asm volatile("s_waitcnt lgkmcnt(0)\n\ts_barrier":::"memory");
  #undef DMA_K
  #undef DMA_V
  #undef CMASK
  #undef START
  #undef RESC
  #undef ROT
}
constexpr int ATTN_LDS_BYTES=LDS_BYTES;
#undef SBAR
#undef WAIT_BAR
}

__device__ __forceinline__ void ph_attn(int wv, int layer, LAS unsigned char* lds) {
    const Params p = load_params();
    PHASE_IDS();
    const int tid = tid_;
    const attn_body::bf16* QB = (const attn_body::bf16*)(p.ws + OFF_QB); const attn_body::bf16* KB = (const attn_body::bf16*)(p.ws + OFF_KB); const attn_body::bf16* VN = (const attn_body::bf16*)(p.ws + OFF_VT);
    attn_body::bf16* Y = (attn_body::bf16*)(p.ws + OFF_Y);
    constexpr int NFULL = 512 - ATT_NSU, NSPLIT = ATT_NSU * 3;
    attn_body::bf16* PO = (attn_body::bf16*)(p.ws + OFF_APO); float* AML = (float*)(p.ws + OFF_AML);
    const int nunits = NFULL + NSPLIT + (layer == 0 ? 16 : 0);
    unsigned* qctr = (unsigned*)(p.ws + OFF_CTL) + 64 * (1 + layer);
    LAS int* su = (LAS int*)(lds + 90112);
    static_assert(attn_body::ATTN_LDS_BYTES <= 90112, "attention LDS map");
    for (;;) {
        __syncthreads();
        if (tid == 0) *su = (int)atomicAdd(qctr, 1u);
        __syncthreads();
        const int u = *su;
        if (u >= nunits) break;
        int b, h, row0, nkt, kt0 = 0, combo = -1;
        if (u < NFULL) { b = u >> 8; h = (u >> 5) & 7; row0 = b * SEQ + (u & 31) * 256; nkt = KPOS / 64; }
        else if (u < NFULL + NSPLIT) { combo = u - NFULL; const int fu = NFULL + combo / 3; b = fu >> 8; h = (fu >> 5) & 7; row0 = b * SEQ + (fu & 31) * 256; nkt = KPOS / 64 / 3; kt0 = (combo % 3) * nkt; }
        else { const int v = u - NFULL - NSPLIT; b = v >> 3; h = v & 7; row0 = NLAT + b * CTXL; nkt = CTXL / 64; }
        const int g = h >> 2;
        const attn_body::bf16* Kh = KB + ((size_t)(b * 2 + g) * KPOS + (size_t)kt0 * 64) * 64;
        const attn_body::bf16* Vh = VN + ((size_t)(b * 2 + g) * KPOS + (size_t)kt0 * 64) * 64;
        if (combo < 0) attn_body::attn_unit<8>(tid, nkt, QB + (size_t)row0 * 512 + h * 64, Kh, Vh, Y + (size_t)row0 * DM + h * 64, (char*)lds);
        else attn_body::attn_unit<8>(tid, nkt, QB + (size_t)row0 * 512 + h * 64, Kh, Vh, PO + (size_t)(combo >> 4) * 256 * DM + (combo & 15) * 64, (char*)lds, AML + (size_t)combo * 512);
    }
}

__device__ __forceinline__ int scan_row(int step, int b, int dir, bool& is_ctx) {
    if (step < CTXL) { is_ctx = true; const int m = dir ? CTXL - 1 - step : step; return NLAT + b * CTXL + m; }
    is_ctx = false; const int n = step - CTXL; return b * SEQ + (dir ? SEQ - 1 - n : n);
}
__device__ __forceinline__ void ph_scan(int wv, int layer) {
    const Params p = load_params();
    int wv_ = __builtin_amdgcn_readfirstlane(wv); asm volatile("" : "+s"(wv_)); int tid_; { int l_; asm volatile("v_mbcnt_lo_u32_b32 %0, -1, 0\n\tv_mbcnt_hi_u32_b32 %0, -1, %0" : "=v"(l_)); tid_ = wv_ * 64 + l_; } int bid_ = blockIdx.x; asm volatile("" : "+s"(bid_)); int nblk_ = gridDim.x; asm volatile("" : "+s"(nblk_));
    if (tid_ >= 64) return;
    const int lane = tid_;
    if ((bid_ & 7) != 0) return;
    const int chain = bid_ >> 3;
    if (chain >= 32) return;
    const int kind = chain >> 4, b = (chain >> 3) & 1, h = (chain >> 1) & 3, dir = chain & 1;
    const bf16_t* P = (const bf16_t*)(p.ws + OFF_PB);
    const float* G = (const float*)(p.ws + OFF_G);
    if (kind == 0) {
        float* MLH = (float*)(p.ws + OFF_MLH) + (size_t)dir * NROW * 256;
        const float ib = p.in[I_MLIB][layer * 8 + dir * 4 + h], fb = p.in[I_MLFB][layer * 8 + dir * 4 + h];
        float C[64];
#pragma unroll
        for (int i = 0; i < 64; ++i) C[i] = 0.f;
        float nvec = 0.f, mrun = 0.f;
        bool ic; int r = scan_row(0, b, dir, ic);
        float q = bf2f(P[(size_t)r * NPC + 768 + h * 64 + lane]), k = bf2f(P[(size_t)r * NPC + 1024 + h * 64 + lane]) * 0.125f, v = bf2f(P[(size_t)r * NPC + 1280 + h * 64 + lane]);
        float ig = G[(size_t)r * NGC + dir * 4 + h] + ib, fg = G[(size_t)r * NGC + 8 + dir * 4 + h] + fb;
        for (int step = 0; step < KPOS; ++step) {
            const int rcur = r; const bool iccur = ic;
            const float qc = q, kc = k, vc = v, igc = ig, fgc = fg;
            if (step + 1 < KPOS) {
                r = scan_row(step + 1, b, dir, ic);
                q = bf2f(P[(size_t)r * NPC + 768 + h * 64 + lane]); k = bf2f(P[(size_t)r * NPC + 1024 + h * 64 + lane]) * 0.125f; v = bf2f(P[(size_t)r * NPC + 1280 + h * 64 + lane]);
                ig = G[(size_t)r * NGC + dir * 4 + h] + ib; fg = G[(size_t)r * NGC + 8 + dir * 4 + h] + fb;
            }
            const float lf = logsigmoidf_(fgc);
            const float mnew = fmaxf(lf + mrun, igc);
            const float fd = expf(lf + mrun - mnew), iw = expf(igc - mnew);
            mrun = mnew;
            nvec = fd * nvec + iw * kc;
            const float den = wave_sum(nvec * qc);
            const float wv = iw * vc;
            float num0 = 0.f, num1 = 0.f;
#pragma unroll
            for (int i = 0; i < 64; i += 2) {
                C[i] = fd * C[i] + rdlane(kc, i) * wv; num0 += rdlane(qc, i) * C[i];
                C[i + 1] = fd * C[i + 1] + rdlane(kc, i + 1) * wv; num1 += rdlane(qc, i + 1) * C[i + 1];
            }
            const float hh = (num0 + num1) / fmaxf(fabsf(den), expf(-mnew));
            if (!iccur || layer == 0) MLH[(size_t)rcur * 256 + h * 64 + lane] = hh;
        }
    } else {
        float* GDO = (float*)(p.ws + OFF_GDO) + (size_t)dir * NROW * 256;
        const bf16_t* GQ = (const bf16_t*)(p.ws + OFF_GQB); const bf16_t* GK = (const bf16_t*)(p.ws + OFF_GKB); const bf16_t* GV = (const bf16_t*)(p.ws + OFF_GVB);
        const float Aneg = -expf(p.in[I_GAL][layer * 8 + dir * 4 + h]), dtb = p.in[I_GDT][layer * 8 + dir * 4 + h];
        float S[64];
#pragma unroll
        for (int i = 0; i < 64; ++i) S[i] = 0.f;
        bool ic; int r = scan_row(0, b, dir, ic);
        float q = bf2f(GQ[(size_t)r * 256 + h * 64 + lane]), k = bf2f(GK[(size_t)r * 256 + h * 64 + lane]), v = bf2f(GV[(size_t)r * 256 + h * 64 + lane]);
        float ag = G[(size_t)r * NGC + 16 + dir * 4 + h], bg = G[(size_t)r * NGC + 24 + dir * 4 + h];
        for (int step = 0; step < KPOS; ++step) {
            const int rcur = r; const bool iccur = ic;
            const float qc = q, kc = k, vc = v, agc = ag, bgc = bg;
            if (step + 1 < KPOS) {
                r = scan_row(step + 1, b, dir, ic);
                q = bf2f(GQ[(size_t)r * 256 + h * 64 + lane]); k = bf2f(GK[(size_t)r * 256 + h * 64 + lane]); v = bf2f(GV[(size_t)r * 256 + h * 64 + lane]);
                ag = G[(size_t)r * NGC + 16 + dir * 4 + h]; bg = G[(size_t)r * NGC + 24 + dir * 4 + h];
            }
            const float alpha = expf(Aneg * softplusf_(agc + dtb));
            const float beta = sigmoidf_(bgc);
            float r0 = 0.f, r1 = 0.f;
#pragma unroll
            for (int i = 0; i < 64; i += 2) { S[i] *= alpha; r0 += S[i] * rdlane(kc, i); S[i + 1] *= alpha; r1 += S[i + 1] * rdlane(kc, i + 1); }
            const float vn = beta * (vc - (r0 + r1));
            float o0 = 0.f, o1 = 0.f;
#pragma unroll
            for (int i = 0; i < 64; i += 2) { S[i] += rdlane(kc, i) * vn; o0 += S[i] * rdlane(qc, i); S[i + 1] += rdlane(kc, i + 1) * vn; o1 += S[i + 1] * rdlane(qc, i + 1); }
            if (!iccur || layer == 0) GDO[(size_t)rcur * 256 + h * 64 + lane] = o0 + o1;
        }
    }
}

__device__ __forceinline__ void fnma_asm(float& acc, float a, float b) { asm("v_fma_f32 %0, -%1, %2, %0" : "+v"(acc) : "v"(a), "v"(b)); }
__device__ __forceinline__ void pk_fnma_lo(f32x2& acc, const f32x2 xk, const f32x2 a) { asm("v_pk_fma_f32 %0, %1, %2, %0 op_sel:[0,0,0] op_sel_hi:[0,1,1] neg_lo:[1,0,0] neg_hi:[1,0,0]" : "+v"(acc) : "v"(xk), "v"(a)); }
__device__ __forceinline__ void pk_fnma_hi(f32x2& acc, const f32x2 xk, const f32x2 a) { asm("v_pk_fma_f32 %0, %1, %2, %0 op_sel:[1,0,0] op_sel_hi:[1,1,1] neg_lo:[1,0,0] neg_hi:[1,0,0]" : "+v"(acc) : "v"(xk), "v"(a)); }
__device__ __forceinline__ f32x16 mfma32(bf16x8 a, bf16x8 b, f32x16 c) { return __builtin_amdgcn_mfma_f32_32x32x16_bf16(a, b, c, 0, 0, 0); }
template <int U> __device__ __forceinline__ bf16x8 acc_frag(const f32x16& a) {
    u32x4 w; w.x = pk_bf16(a[8 * U + 0], a[8 * U + 1]); w.y = pk_bf16(a[8 * U + 2], a[8 * U + 3]); w.z = pk_bf16(a[8 * U + 4], a[8 * U + 5]); w.w = pk_bf16(a[8 * U + 6], a[8 * U + 7]);
    return __builtin_bit_cast(bf16x8, w);
}
__device__ __forceinline__ bf16x8 gather_lds(const LAS bf16_t* tile, int ks, int hi, int col) {
    const LAS bf16_t* b = tile + (4 * hi) * 64 + col; bf16x8 f;
#pragma unroll
    for (int j = 0; j < 8; ++j) f[j] = (short)b[(16 * ks + 8 * (j >> 2) + (j & 3)) * 64];
    return f;
}
template <int U> __device__ __forceinline__ bf16x8 acc_frag_s(const f32x16& a, const float (&s)[16]) {
    u32x4 w; w.x = pk_bf16(a[8 * U + 0] * s[8 * U + 0], a[8 * U + 1] * s[8 * U + 1]); w.y = pk_bf16(a[8 * U + 2] * s[8 * U + 2], a[8 * U + 3] * s[8 * U + 3]);
    w.z = pk_bf16(a[8 * U + 4] * s[8 * U + 4], a[8 * U + 5] * s[8 * U + 5]); w.w = pk_bf16(a[8 * U + 6] * s[8 * U + 6], a[8 * U + 7] * s[8 * U + 7]);
    return __builtin_bit_cast(bf16x8, w);
}
__device__ __forceinline__ bf16x8 mk_frag(u32x2 lo, u32x2 hi8) { return __builtin_bit_cast(bf16x8, (u32x4){lo.x, lo.y, hi8.x, hi8.y}); }
__device__ __forceinline__ bf16x8 ld_perm(const bf16_t* rowk0, int hi) { return mk_frag(*(const u32x2*)(rowk0 + 4 * hi), *(const u32x2*)(rowk0 + 8 + 4 * hi)); }
__device__ __forceinline__ float bperm(float v, int srclane) { return __builtin_bit_cast(float, __builtin_amdgcn_ds_bpermute(srclane << 2, __builtin_bit_cast(int, v))); }
__device__ __forceinline__ float scan_add64(float v, int lane) {
#pragma unroll
    for (int o = 1; o < 64; o <<= 1) { const float t = bperm(v, lane - o); if (lane >= o) v += t; }
    return v;
}
__device__ __forceinline__ float scan_max64(float v, int lane) {
#pragma unroll
    for (int o = 1; o < 64; o <<= 1) { const float t = bperm(v, lane - o); if (lane >= o) v = fmaxf(v, t); }
    return v;
}
struct ChunkRows { int r0, sgn; };
__device__ __forceinline__ ChunkRows chunk_rows(int b, int dir, int c) {
    ChunkRows cr; cr.sgn = dir ? -1 : 1;
    if (c < 4) cr.r0 = NLAT + b * CTXL + (dir ? CTXL - 1 - 64 * c : 64 * c);
    else cr.r0 = b * SEQ + (dir ? SEQ - 1 - 64 * (c - 4) : 64 * (c - 4));
    return cr;
}
__device__ __forceinline__ bf16x8 gather_perm(const bf16_t* base, int ld, ChunkRows cr, int ks, int hi, int col) {
    bf16x8 f;
#pragma unroll
    for (int j = 0; j < 8; ++j) { const int tau = 16 * ks + 8 * (j >> 2) + 4 * hi + (j & 3); f[j] = (short)base[(size_t)(cr.r0 + cr.sgn * tau) * ld + col]; }
    return f;
}
__device__ __forceinline__ void st_frag(GAS float* dst, int lane, const f32x16& a) {
    GAS float* d = dst + lane * 4;
#pragma unroll
    for (int q = 0; q < 4; ++q) *(GAS f32x4*)(d + 256 * q) = (f32x4){a[4 * q], a[4 * q + 1], a[4 * q + 2], a[4 * q + 3]};
}
__device__ __forceinline__ f32x16 ld_frag(const GAS float* src, int lane) {
    const GAS float* d = src + lane * 4; f32x16 a;
#pragma unroll
    for (int q = 0; q < 4; ++q) { const f32x4 v = *(const GAS f32x4*)(d + 256 * q); a[4 * q] = v.x; a[4 * q + 1] = v.y; a[4 * q + 2] = v.z; a[4 * q + 3] = v.w; }
    return a;
}
__device__ __forceinline__ void ld_rowvec_lds(const LAS float* vec, int blk, int hi, float (&out)[16]) {
#pragma unroll
    for (int q = 0; q < 4; ++q) { const f32x4 v = *(const LAS f32x4*)(vec + 32 * blk + 8 * q + 4 * hi); out[4 * q] = v.x; out[4 * q + 1] = v.y; out[4 * q + 2] = v.z; out[4 * q + 3] = v.w; }
}
__device__ __forceinline__ void ld_rowvec_g(const float* vec, int blk, int hi, float (&out)[16]) {
#pragma unroll
    for (int q = 0; q < 4; ++q) { const f32x4 v = *(const f32x4*)(vec + 32 * blk + 8 * q + 4 * hi); out[4 * q] = v.x; out[4 * q + 1] = v.y; out[4 * q + 2] = v.z; out[4 * q + 3] = v.w; }
}

__device__ __forceinline__ float fexp(float x) { return __builtin_amdgcn_exp2f(x * 1.4426950408889634f); }
__device__ __forceinline__ void mlstm_A_unit(const Params& p, int layer, int chain, int c, int lane_in, LAS float* wl) {
    int lane = lane_in; asm volatile("" : "+v"(lane));
    const int b = chain >> 3, h = (chain >> 1) & 3, dir = chain & 1, r_ = lane & 31, hi = lane >> 5;
    const ChunkRows cr = chunk_rows(b, dir, c);
    const bf16_t* Pb = (const bf16_t*)(p.ws + OFF_PB);
    const float* G = (const float*)(p.ws + OFF_G);
    const int uid = chain * NCHUNK + c;
    float* VEC = (float*)(p.ws + OFF_MLVEC) + (size_t)uid * 320;
    GAS float* NUM = (GAS float*)(p.ws + OFF_MLNUM) + (size_t)uid * 4096;
    GAS float* KL = (GAS float*)(p.ws + OFF_MLKL) + (size_t)uid * 4096;
    const int rt = cr.r0 + cr.sgn * lane;
    const float ig = G[(size_t)rt * NGC + dir * 4 + h] + p.in[I_MLIB][layer * 8 + dir * 4 + h];
    const float fg = G[(size_t)rt * NGC + 8 + dir * 4 + h] + p.in[I_MLFB][layer * 8 + dir * 4 + h];
    const float bb = scan_add64(logsigmoidf_(fg), lane);
    const float cc = ig - bb;
    const float gcm = scan_max64(cc, lane);
    const float Btot = rdlane(bb, 63), gmax = rdlane(gcm, 63);
    wl[lane] = cc; wl[64 + lane] = gcm; wl[128 + lane] = fexp(cc - gmax) * 0.125f;
    VEC[128 + lane] = bb + gcm; VEC[192 + lane] = bb;
    if (lane == 0) { VEC[256] = Btot + gmax; VEC[257] = Btot; }
    f32x16 X[2][2];
    {
        bf16x8 Kf[2][4], Qf[2][4];
#pragma unroll
        for (int blk = 0; blk < 2; ++blk)
#pragma unroll
            for (int ks = 0; ks < 4; ++ks) {
                const bf16_t* rp = Pb + (size_t)(cr.r0 + cr.sgn * (32 * blk + r_)) * NPC + h * 64 + 16 * ks + 8 * hi;
                Kf[blk][ks] = *(const bf16x8*)(rp + 1024); Qf[blk][ks] = *(const bf16x8*)(rp + 768);
            }
#pragma unroll
        for (int sb = 0; sb < 2; ++sb)
#pragma unroll
            for (int tb = 0; tb < 2; ++tb) {
                f32x16 a = {};
#pragma unroll
                for (int ks = 0; ks < 4; ++ks) a = mfma32(Kf[sb][ks], Qf[tb][ks], a);
                X[sb][tb] = a;
            }
        GAS u32x4* QP = (GAS u32x4*)(p.ws + OFF_MLQP) + (size_t)uid * 512;
#pragma unroll
        for (int tb = 0; tb < 2; ++tb)
#pragma unroll
            for (int ks = 0; ks < 4; ++ks) {
                const u32x4 nat = __builtin_bit_cast(u32x4, Qf[tb][ks]);
                auto s02 = __builtin_amdgcn_permlane32_swap(nat.x, nat.z, false, false);
                auto s13 = __builtin_amdgcn_permlane32_swap(nat.y, nat.w, false, false);
                QP[(tb * 4 + ks) * 64 + lane] = (u32x4){s02[0], s13[0], s02[1], s13[1]};
            }
    }
#pragma unroll
    for (int tb = 0; tb < 2; ++tb) {
        const int t = 32 * tb + r_; const float gt = wl[64 + t]; float dsum = 0.f;
#pragma unroll
        for (int sb = 0; sb < 2; ++sb) {
            float cs[16]; ld_rowvec_lds(wl, sb, hi, cs);
#pragma unroll
            for (int g = 0; g < 16; ++g) {
                const int s = 32 * sb + (g & 3) + 8 * (g >> 2) + 4 * hi;
                const float w = (s <= t) ? fexp(cs[g] - gt) * 0.125f : 0.f;
                X[sb][tb][g] *= w; dsum += X[sb][tb][g];
            }
        }
        dsum += xor_lane<32>(dsum);
        if (hi == 0) VEC[64 + t] = dsum;
    }
    bf16x8 Vg[2][4];
#pragma unroll
    for (int db = 0; db < 2; ++db)
#pragma unroll
        for (int ks = 0; ks < 4; ++ks) Vg[db][ks] = gather_perm(Pb, NPC, cr, ks, hi, 1280 + h * 64 + 32 * db + r_);
#pragma unroll
    for (int tb = 0; tb < 2; ++tb)
#pragma unroll
        for (int db = 0; db < 2; ++db) {
            f32x16 a = {};
            a = mfma32(acc_frag<0>(X[0][tb]), Vg[db][0], a); a = mfma32(acc_frag<1>(X[0][tb]), Vg[db][1], a);
            a = mfma32(acc_frag<0>(X[1][tb]), Vg[db][2], a); a = mfma32(acc_frag<1>(X[1][tb]), Vg[db][3], a);
            st_frag(NUM + (tb * 2 + db) * 1024, lane, a);
        }
#pragma unroll
    for (int kb = 0; kb < 2; ++kb) {
        bf16x8 Af[4]; float nl = 0.f;
#pragma unroll
        for (int ks = 0; ks < 4; ++ks) {
            const bf16x8 raw = gather_perm(Pb, NPC, cr, ks, hi, 1024 + h * 64 + 32 * kb + r_);
            const f32x4 a0 = *(const LAS f32x4*)(wl + 128 + 16 * ks + 4 * hi), a1 = *(const LAS f32x4*)(wl + 128 + 16 * ks + 8 + 4 * hi);
            float e[8];
#pragma unroll
            for (int j = 0; j < 4; ++j) { e[j] = bf2f((bf16_t)raw[j]) * a0[j]; e[4 + j] = bf2f((bf16_t)raw[4 + j]) * a1[j]; }
#pragma unroll
            for (int j = 0; j < 8; ++j) nl += e[j];
            u32x4 w; w.x = pk_bf16(e[0], e[1]); w.y = pk_bf16(e[2], e[3]); w.z = pk_bf16(e[4], e[5]); w.w = pk_bf16(e[6], e[7]);
            Af[ks] = __builtin_bit_cast(bf16x8, w);
        }
        nl += xor_lane<32>(nl);
        if (hi == 0) VEC[32 * kb + r_] = nl;
#pragma unroll
        for (int db = 0; db < 2; ++db) {
            f32x16 a = {};
#pragma unroll
            for (int ks = 0; ks < 4; ++ks) a = mfma32(Af[ks], Vg[db][ks], a);
            st_frag(KL + (kb * 2 + db) * 1024, lane, a);
        }
    }
}

__device__ __forceinline__ void gdn_A_unit(const Params& p, int layer, int chain, int c, int lane_in, LAS float* wl) {
    int lane = lane_in; asm volatile("" : "+v"(lane));
    const int b = chain >> 3, h = (chain >> 1) & 3, dir = chain & 1, r_ = lane & 31, hi = lane >> 5;
    const ChunkRows cr = chunk_rows(b, dir, c);
    const bf16_t* GQ = (const bf16_t*)(p.ws + OFF_GQB); const bf16_t* GK = (const bf16_t*)(p.ws + OFF_GKB); const bf16_t* GV = (const bf16_t*)(p.ws + OFF_GVB);
    const float* G = (const float*)(p.ws + OFF_G);
    const int uid = chain * NCHUNK + c;
    GAS bf16_t* MW = (GAS bf16_t*)(p.ws + OFF_GDMW) + (size_t)uid * 4096;
    GAS float* NM = (GAS float*)(p.ws + OFF_GDN) + (size_t)uid * 4096;
    GAS bf16_t* QE = (GAS bf16_t*)(p.ws + OFF_GDQE) + (size_t)uid * 4096;
    GAS float* OL = (GAS float*)(p.ws + OFF_GDOL) + (size_t)uid * 4096;
    LAS float* AL = wl + 192;
    LAS bf16_t* PmL = (LAS bf16_t*)(wl + 192);
    const int rt = cr.r0 + cr.sgn * lane;
    const float gl = -fexp(p.in[I_GAL][layer * 8 + dir * 4 + h]) * softplusf_(G[(size_t)rt * NGC + 16 + dir * 4 + h] + p.in[I_GDT][layer * 8 + dir * 4 + h]);
    const float beta = sigmoidf_(G[(size_t)rt * NGC + 24 + dir * 4 + h]);
    const float Gc = scan_add64(gl, lane);
    const float Glast = rdlane(Gc, 63);
    wl[lane] = Gc; wl[64 + lane] = fexp(Glast - Gc); wl[128 + lane] = beta;
    if (lane == 0) ((float*)(p.ws + OFF_GDSC))[uid] = fexp(Glast);
    f32x2 xp[32];
    {
        f32x16 KK[2][2];
        {
            bf16x8 Kr[2][4];
#pragma unroll
            for (int blk = 0; blk < 2; ++blk)
#pragma unroll
                for (int ks = 0; ks < 4; ++ks) Kr[blk][ks] = *(const bf16x8*)(GK + (size_t)(cr.r0 + cr.sgn * (32 * blk + r_)) * 256 + h * 64 + 16 * ks + 8 * hi);
#pragma unroll
            for (int ib = 0; ib < 2; ++ib)
#pragma unroll
                for (int jb = 0; jb < 2; ++jb) {
                    f32x16 a = {};
#pragma unroll
                    for (int ks = 0; ks < 4; ++ks) a = mfma32(Kr[ib][ks], Kr[jb][ks], a);
                    KK[ib][jb] = a;
                }
        }
#pragma unroll
        for (int ib = 0; ib < 2; ++ib) {
            float Gi[16], bi[16]; ld_rowvec_lds(wl, ib, hi, Gi); ld_rowvec_lds(wl + 128, ib, hi, bi);
#pragma unroll
            for (int jb = 0; jb < 2; ++jb) {
                const int j = 32 * jb + r_; const float Gj = wl[j];
#pragma unroll
                for (int g = 0; g < 16; ++g)
                    AL[(32 * ib + (g & 3) + 8 * (g >> 2) + 4 * hi) * 68 + j] = KK[ib][jb][g] * bi[g] * fexp(fminf(Gi[g] - Gj, 0.f));
            }
        }
#pragma unroll
        for (int j = 0; j < 32; ++j) xp[j] = (f32x2){(lane == 2 * j) ? 1.f : 0.f, (lane == 2 * j + 1) ? 1.f : 0.f};
#pragma unroll
        for (int k = 63; k >= 1; --k) {
#pragma unroll
            for (int j4 = 0; j4 < k; j4 += 4) {
                const f32x4 a = *(const volatile LAS f32x4*)(AL + k * 68 + j4);
                const f32x2 xk = xp[k >> 1];
#pragma unroll
                for (int h2 = 0; h2 < 2; ++h2) {
                    const int j = j4 + 2 * h2;
                    const f32x2 ap = h2 ? (f32x2){a.z, a.w} : (f32x2){a.x, a.y};
                    if (j + 1 < k) { if (k & 1) pk_fnma_hi(xp[j >> 1], xk, ap); else pk_fnma_lo(xp[j >> 1], xk, ap); }
                    else if (j < k) { float t = xp[j >> 1].x; fnma_asm(t, xk.y, ap.x); xp[j >> 1].x = t; }
                }
            }
            __builtin_amdgcn_sched_barrier(0);
        }
    }
    __builtin_amdgcn_sched_barrier(0);
    unsigned tbd[32];
#pragma unroll
    for (int d = 0; d < 32; ++d) {
        tbd[d] = pk_bf16(xp[d].x * wl[128 + 2 * d], xp[d].y * wl[128 + 2 * d + 1]);
    }
    __builtin_amdgcn_sched_barrier(0);
    LAS bf16_t* KtL = (LAS bf16_t*)AL; LAS bf16_t* VtL = KtL + 4096;
    {
        const bf16_t* GK2 = GK; const bf16_t* GV2 = GV; asm volatile("" : "+s"(GK2), "+s"(GV2));
        const GAS bf16_t* gk = (const GAS bf16_t*)GK2; const GAS bf16_t* gv = (const GAS bf16_t*)GV2;
#pragma unroll
        for (int i = 0; i < 8; ++i) {
            const int row = i * 8 + (lane >> 3), ch = lane & 7;
            const size_t go = (size_t)(cr.r0 + cr.sgn * row) * 256 + h * 64 + ch * 8;
            *(LAS u32x4*)(KtL + row * 64 + ch * 8) = *(const GAS u32x4*)(gk + go);
            *(LAS u32x4*)(VtL + row * 64 + ch * 8) = *(const GAS u32x4*)(gv + go);
        }
    }
    constexpr int LO[4] = {0, 1, 4, 5}, HI[4] = {2, 3, 6, 7};
    bf16x8 Uf[2][4], Wf[2][4];
#pragma unroll
    for (int db = 0; db < 2; ++db) {
        f32x16 U0 = {}, U1 = {};
#pragma unroll
        for (int ks = 0; ks < 4; ++ks) {
            u32x4 f0, f1;
#pragma unroll
            for (int q = 0; q < 4; ++q) { auto rb = __builtin_amdgcn_permlane32_swap(tbd[8 * ks + LO[q]], tbd[8 * ks + HI[q]], false, false); f0[q] = rb[0]; f1[q] = rb[1]; }
            const bf16x8 Vp = gather_lds(VtL, ks, hi, 32 * db + r_);
            U0 = mfma32(__builtin_bit_cast(bf16x8, f0), Vp, U0); U1 = mfma32(__builtin_bit_cast(bf16x8, f1), Vp, U1);
        }
        float el0[16], el1[16]; ld_rowvec_lds(wl + 64, 0, hi, el0); ld_rowvec_lds(wl + 64, 1, hi, el1);
        const bf16x8 s0 = acc_frag_s<0>(U0, el0), s1 = acc_frag_s<1>(U0, el0), s2 = acc_frag_s<0>(U1, el1), s3 = acc_frag_s<1>(U1, el1);
#pragma unroll
        for (int kb = 0; kb < 2; ++kb) {
            f32x16 n = {};
            n = mfma32(gather_lds(KtL, 0, hi, 32 * kb + r_), s0, n); n = mfma32(gather_lds(KtL, 1, hi, 32 * kb + r_), s1, n);
            n = mfma32(gather_lds(KtL, 2, hi, 32 * kb + r_), s2, n); n = mfma32(gather_lds(KtL, 3, hi, 32 * kb + r_), s3, n);
            st_frag(NM + (kb * 2 + db) * 1024, lane, n);
        }
        Uf[db][0] = acc_frag<0>(U0); Uf[db][1] = acc_frag<1>(U0); Uf[db][2] = acc_frag<0>(U1); Uf[db][3] = acc_frag<1>(U1);
        __builtin_amdgcn_sched_barrier(0);
    }
#pragma unroll
    for (int i = 0; i < 8; ++i) {
        const int row = i * 8 + (lane >> 3), ch = lane & 7;
        const bf16x8 kv = *(const LAS bf16x8*)(KtL + row * 64 + ch * 8);
        const float sc = fexp(wl[row]);
        u32x4 o;
        o.x = pk_bf16(bf2f((bf16_t)kv[0]) * sc, bf2f((bf16_t)kv[1]) * sc); o.y = pk_bf16(bf2f((bf16_t)kv[2]) * sc, bf2f((bf16_t)kv[3]) * sc);
        o.z = pk_bf16(bf2f((bf16_t)kv[4]) * sc, bf2f((bf16_t)kv[5]) * sc); o.w = pk_bf16(bf2f((bf16_t)kv[6]) * sc, bf2f((bf16_t)kv[7]) * sc);
        *(LAS u32x4*)(VtL + row * 64 + ch * 8) = o;
    }
#pragma unroll
    for (int db = 0; db < 2; ++db) {
        f32x16 W0 = {}, W1 = {};
#pragma unroll
        for (int ks = 0; ks < 4; ++ks) {
            u32x4 f0, f1;
#pragma unroll
            for (int q = 0; q < 4; ++q) { auto rg = __builtin_amdgcn_permlane32_swap(tbd[8 * ks + LO[q]], tbd[8 * ks + HI[q]], false, false); f0[q] = rg[0]; f1[q] = rg[1]; }
            const bf16x8 Kp = gather_lds(VtL, ks, hi, 32 * db + r_);
            W0 = mfma32(__builtin_bit_cast(bf16x8, f0), Kp, W0); W1 = mfma32(__builtin_bit_cast(bf16x8, f1), Kp, W1);
        }
        float el0[16], el1[16]; ld_rowvec_lds(wl + 64, 0, hi, el0); ld_rowvec_lds(wl + 64, 1, hi, el1);
        const bf16x8 s0 = acc_frag_s<0>(W0, el0), s1 = acc_frag_s<1>(W0, el0), s2 = acc_frag_s<0>(W1, el1), s3 = acc_frag_s<1>(W1, el1);
#pragma unroll
        for (int kbp = 0; kbp < 2; ++kbp) {
            f32x16 a = {};
            a = mfma32(gather_lds(KtL, 0, hi, 32 * kbp + r_), s0, a); a = mfma32(gather_lds(KtL, 1, hi, 32 * kbp + r_), s1, a);
            a = mfma32(gather_lds(KtL, 2, hi, 32 * kbp + r_), s2, a); a = mfma32(gather_lds(KtL, 3, hi, 32 * kbp + r_), s3, a);
            GAS bf16_t* mwb = MW + ((kbp * 4 + 2 * db + (r_ >> 4)) * 64 + 32 * ((r_ >> 2) & 1) + 4 * hi) * 8 + 4 * ((r_ >> 3) & 1) + (r_ & 3);
#pragma unroll
            for (int g = 0; g < 16; ++g) mwb[((g & 3) + 8 * (g >> 2)) * 8] = f2bf(-a[g]);
        }
        Wf[db][0] = acc_frag<0>(W0); Wf[db][1] = acc_frag<1>(W0); Wf[db][2] = acc_frag<0>(W1); Wf[db][3] = acc_frag<1>(W1);
        __builtin_amdgcn_sched_barrier(0);
    }
    LAS bf16x8* WfL = (LAS bf16x8*)((LAS bf16_t*)AL + 4352);
#pragma unroll
    for (int db = 0; db < 2; ++db)
#pragma unroll
        for (int ks = 0; ks < 4; ++ks) WfL[(db * 4 + ks) * 64 + lane] = Wf[db][ks];
    __builtin_amdgcn_sched_barrier(0);
    const GAS bf16_t* gq;
    { const bf16_t* GQ3 = GQ; asm volatile("" : "+s"(GQ3)); gq = (const GAS bf16_t*)GQ3; }
    {
        bf16x8 Kr[2][4];
#pragma unroll
        for (int blk = 0; blk < 2; ++blk)
#pragma unroll
            for (int ks = 0; ks < 4; ++ks) Kr[blk][ks] = *(const LAS bf16x8*)(KtL + (32 * blk + r_) * 64 + 16 * ks + 8 * hi);
        __builtin_amdgcn_sched_barrier(0);
#pragma unroll
        for (int tb = 0; tb < 2; ++tb) {
            bf16x8 Qr[4];
#pragma unroll
            for (int ks = 0; ks < 4; ++ks) Qr[ks] = *(const GAS bf16x8*)(gq + (size_t)(cr.r0 + cr.sgn * (32 * tb + r_)) * 256 + h * 64 + 16 * ks + 8 * hi);
            float Gt[16]; ld_rowvec_lds(wl, tb, hi, Gt);
#pragma unroll
            for (int sb = 0; sb < 2; ++sb) {
                f32x16 a = {};
#pragma unroll
                for (int ks = 0; ks < 4; ++ks) a = mfma32(Qr[ks], Kr[sb][ks], a);
                const int s = 32 * sb + r_; const float Gs = wl[s];
#pragma unroll
                for (int g = 0; g < 16; ++g) {
                    const int t = 32 * tb + (g & 3) + 8 * (g >> 2) + 4 * hi;
                    const float v = (s <= t) ? a[g] * fexp(fminf(Gt[g] - Gs, 0.f)) : 0.f;
                    PmL[t * 68 + s] = f2bf(v);
                }
            }
            __builtin_amdgcn_sched_barrier(0);
        }
    }
    __builtin_amdgcn_sched_barrier(0);
    int r2 = r_, h2 = hi; asm volatile("" : "+v"(r2), "+v"(h2));
#pragma unroll
    for (int tb = 0; tb < 2; ++tb) {
        bf16x8 Pf[4];
#pragma unroll
        for (int ks = 0; ks < 4; ++ks) {
            const LAS bf16_t* rp = PmL + (32 * tb + r_) * 68 + 16 * ks;
            Pf[ks] = mk_frag(*(const LAS u32x2*)(rp + 4 * hi), *(const LAS u32x2*)(rp + 8 + 4 * hi));
        }
        float Gt[16]; ld_rowvec_lds(wl, tb, hi, Gt);
#pragma unroll
        for (int db = 0; db < 2; ++db) {
            f32x16 o = {};
#pragma unroll
            for (int ks = 0; ks < 4; ++ks) o = mfma32(Pf[ks], Uf[db][ks], o);
            st_frag(OL + (tb * 2 + db) * 1024, lane, o);
            f32x16 e = {};
#pragma unroll
            for (int ks = 0; ks < 4; ++ks) e = mfma32(Pf[ks], WfL[(db * 4 + ks) * 64 + lane], e);
            GAS bf16_t* qeb = QE + ((tb * 4 + 2 * db + (r2 >> 4)) * 64 + 32 * ((r2 >> 2) & 1) + 4 * h2) * 8 + 4 * ((r2 >> 3) & 1) + (r2 & 3);
#pragma unroll
            for (int g = 0; g < 16; ++g) {
                const int t = 32 * tb + (g & 3) + 8 * (g >> 2) + 4 * hi;
                const float qv = bf2f(gq[(size_t)(cr.r0 + cr.sgn * t) * 256 + h * 64 + 32 * db + r_]);
                qeb[((g & 3) + 8 * (g >> 2)) * 8] = f2bf(fexp(Gt[g]) * qv - e[g]);
            }
            __builtin_amdgcn_sched_barrier(0);
        }
    }
}

#define MIXA_TAIL_WORD(layer) (XCD_BAR_WORDS + 64 * (1 + (layer)))
template <int PASS> __device__ __forceinline__ void ph_mixA(int wv, int layer, LAS unsigned char* lds) {
    const Params p = load_params();
    PHASE_IDS();
    const int lane = tid_ & 63, wave = tid_ >> 6;
    LAS float* wl = (LAS float*)(lds + wave * 18176);
    if (PASS == 0) {
        const int gw = bid_ * 8 + wave, NGW = nblk_ * 8;
        for (int id = gw; id < 16 * 128; id += NGW) gdn_A_unit(p, layer, id >> 7, id & 127, lane, wl);
        for (int id = gw; id < 16 * 128; id += NGW) mlstm_A_unit(p, layer, id >> 7, id & 127, lane, wl);
    } else {
        const int first = nblk_ > 32 ? 32 : 0, nb = (nblk_ - first) < 16 ? (nblk_ - first) : 16;
        if (bid_ < first || bid_ >= first + nb) return;
        for (int id = (bid_ - first) * 8 + wave; id < 128; id += nb * 8) {
            const int dd = id >> 1;
            if (id & 1) mlstm_A_unit(p, layer, dd >> 2, 128 + (dd & 3), lane, wl); else gdn_A_unit(p, layer, dd >> 2, 128 + (dd & 3), lane, wl);
            asm volatile("s_waitcnt vmcnt(0)" ::: "memory");
            __builtin_amdgcn_fence(__ATOMIC_RELEASE, "agent");
            asm volatile("s_waitcnt vmcnt(0)" ::: "memory");
            if (lane == 0) (void)xb_add(&((unsigned*)(p.ws + OFF_BAR))[MIXA_TAIL_WORD(layer)], 1u);
        }
    }
}
__device__ __forceinline__ void mixA_tail_wait(const Params& p, int layer) {
    unsigned* w = &((unsigned*)(p.ws + OFF_BAR))[MIXA_TAIL_WORD(layer)];
    unsigned sp = 0u;
    while (xb_ld(w) < 128u) { __builtin_amdgcn_s_sleep(2); if (++sp > (1u << 22)) break; }
    __builtin_amdgcn_fence(__ATOMIC_ACQUIRE, "agent");
    asm volatile("s_waitcnt vmcnt(0)" ::: "memory");
}

__device__ __forceinline__ void ph_mixB(int wv, int layer, LAS unsigned char* lds) {
    const Params p = load_params();
    PHASE_IDS();
    if (bid_ >= 32 || (tid_ >> 6) >= 2) return;
    const int lane = tid_ & 63, wave = tid_ >> 6, r_ = lane & 31, hi = lane >> 5;
    const int idx = bid_ * 2 + wave, kind = idx >> 5, chain = (idx >> 1) & 15, db = idx & 1;
    const int b = chain >> 3, h = (chain >> 1) & 3, dir = chain & 1;
    if (kind == 0) {
        LAS float* tab = (LAS float*)(lds + wave * 1024);
        const GAS bf16x8* QPb = (const GAS bf16x8*)(p.ws + OFF_MLQP) + (size_t)chain * NCHUNK * 512;
        GAS float* MLH = (GAS float*)(p.ws + OFF_MLH) + (size_t)dir * NROW * 256;
        const GAS float* VECb = (const GAS float*)(p.ws + OFF_MLVEC) + (size_t)chain * NCHUNK * 320;
        const GAS float* NUMb = (const GAS float*)(p.ws + OFF_MLNUM) + (size_t)chain * NCHUNK * 4096;
        const GAS float* KLb = (const GAS float*)(p.ws + OFF_MLKL) + (size_t)chain * NCHUNK * 4096;
        f32x16 C0 = {}, C1 = {};
        float nmine = 0.f, m = 0.f;
        tab[128 + lane] = 0.f;
        bf16x8 qf[2][4]; float Lt[2], bt[2], dt[2], mloc, Btot, nloc;
        auto prefetch = [&](int c) {
            const GAS float* VEC = VECb + (size_t)c * 320;
#pragma unroll
            for (int tb = 0; tb < 2; ++tb) {
#pragma unroll
                for (int ks = 0; ks < 4; ++ks) qf[tb][ks] = QPb[(size_t)c * 512 + (tb * 4 + ks) * 64 + lane];
                dt[tb] = VEC[64 + 32 * tb + r_]; Lt[tb] = VEC[128 + 32 * tb + r_]; bt[tb] = VEC[192 + 32 * tb + r_];
            }
            nloc = VEC[lane]; mloc = VEC[256]; Btot = VEC[257];
        };
        prefetch(0);
        f32x16 k0 = ld_frag(KLb + (0 * 2 + db) * 1024, lane), k1 = ld_frag(KLb + (1 * 2 + db) * 1024, lane), nl0 = {}, nl1 = {};
        if (layer == 0) { nl0 = ld_frag(NUMb + (0 * 2 + db) * 1024, lane); nl1 = ld_frag(NUMb + (1 * 2 + db) * 1024, lane); }
        for (int c = 0; c < NCHUNK; ++c) {
            const ChunkRows cr = chunk_rows(b, dir, c);
            const bool emit = (c >= 4 || layer == 0);
            const int cn = c + 1 < NCHUNK ? c + 1 : c;
            f32x16 qc0 = {}, qc1 = {};
            if (emit) {
                float pq0 = 0.f, pq1 = 0.f;
#pragma unroll
                for (int ks = 0; ks < 4; ++ks) {
                    const f32x4 na = *(const LAS f32x4*)(tab + 128 + 16 * ks + 4 * hi), nb = *(const LAS f32x4*)(tab + 128 + 16 * ks + 8 + 4 * hi);
#pragma unroll
                    for (int j = 0; j < 4; ++j) {
                        pq0 += bf2f((bf16_t)qf[0][ks][j]) * na[j] + bf2f((bf16_t)qf[0][ks][4 + j]) * nb[j];
                        pq1 += bf2f((bf16_t)qf[1][ks][j]) * na[j] + bf2f((bf16_t)qf[1][ks][4 + j]) * nb[j];
                    }
                }
                pq0 += xor_lane<32>(pq0); pq1 += xor_lane<32>(pq1);
                {
                    const float L = hi ? Lt[1] : Lt[0], bq = hi ? bt[1] : bt[0], dq = hi ? dt[1] : dt[0], qn = hi ? pq1 : pq0;
                    const float inter = bq + m, Mt = fmaxf(L, inter), sA = fexp(L - Mt), sB = fexp(inter - Mt);
                    const float rinv = __builtin_amdgcn_rcpf(fmaxf(fabsf(sA * dq + sB * qn), fexp(-Mt)));
                    tab[lane] = sA * rinv; tab[64 + lane] = sB * rinv;
                }
                bf16x8 Cf[4];
                Cf[0] = acc_frag<0>(C0); Cf[1] = acc_frag<1>(C0); Cf[2] = acc_frag<0>(C1); Cf[3] = acc_frag<1>(C1);
#pragma unroll
                for (int ks = 0; ks < 4; ++ks) { qc0 = mfma32(qf[0][ks], Cf[ks], qc0); qc1 = mfma32(qf[1][ks], Cf[ks], qc1); }
            }
            const float mnew = fmaxf(Btot + m, mloc), dec = fexp(Btot + m - mnew), wlc = fexp(mloc - mnew);
            nmine = dec * nmine + wlc * nloc; m = mnew;
            if (c + 1 == 128) mixA_tail_wait(p, layer);
            if (c + 1 < NCHUNK) prefetch(c + 1);
            if (emit) {
#pragma unroll
                for (int tb = 0; tb < 2; ++tb) {
                    const f32x16& nl = tb ? nl1 : nl0; const f32x16& qc = tb ? qc1 : qc0;
                    GAS float* orow = MLH + (size_t)(cr.r0 + cr.sgn * (32 * tb + 4 * hi)) * 256 + h * 64 + 32 * db + r_;
#pragma unroll
                    for (int q = 0; q < 4; ++q) {
                        const f32x4 a4 = *(const LAS f32x4*)(tab + 32 * tb + 8 * q + 4 * hi), b4 = *(const LAS f32x4*)(tab + 64 + 32 * tb + 8 * q + 4 * hi);
#pragma unroll
                        for (int i = 0; i < 4; ++i) orow[(ptrdiff_t)cr.sgn * ((i + 8 * q) * 256)] = a4[i] * nl[4 * q + i] + b4[i] * qc[4 * q + i];
                    }
                }
            }
            if (cn >= 4 || layer == 0) { nl0 = ld_frag(NUMb + (size_t)cn * 4096 + (0 * 2 + db) * 1024, lane); nl1 = ld_frag(NUMb + (size_t)cn * 4096 + (1 * 2 + db) * 1024, lane); }
#pragma unroll
            for (int g = 0; g < 16; ++g) { C0[g] = dec * C0[g] + wlc * k0[g]; C1[g] = dec * C1[g] + wlc * k1[g]; }
            k0 = ld_frag(KLb + (size_t)cn * 4096 + (0 * 2 + db) * 1024, lane); k1 = ld_frag(KLb + (size_t)cn * 4096 + (1 * 2 + db) * 1024, lane);
            tab[128 + lane] = nmine;
        }
    } else {
        GAS float* GDO = (GAS float*)(p.ws + OFF_GDO) + (size_t)dir * NROW * 256;
        const GAS bf16_t* QEb = (const GAS bf16_t*)(p.ws + OFF_GDQE) + (size_t)chain * NCHUNK * 4096;
        const GAS bf16_t* MWb = (const GAS bf16_t*)(p.ws + OFF_GDMW) + (size_t)chain * NCHUNK * 4096;
        const GAS float* OLb = (const GAS float*)(p.ws + OFF_GDOL) + (size_t)chain * NCHUNK * 4096;
        const GAS float* NMb = (const GAS float*)(p.ws + OFF_GDN) + (size_t)chain * NCHUNK * 4096;
        const GAS float* SCb = (const GAS float*)(p.ws + OFF_GDSC) + (size_t)chain * NCHUNK;
        f32x16 S0 = {}, S1 = {}, N0, N1, O0 = {}, O1 = {};
        bf16x8 qe[2][4], mw[2][4]; float eL;
        auto prefetch = [&](int c) {
            const GAS bf16_t* QE = QEb + (size_t)c * 4096; const GAS bf16_t* MW = MWb + (size_t)c * 4096;
#pragma unroll
            for (int tb = 0; tb < 2; ++tb)
#pragma unroll
                for (int ks = 0; ks < 4; ++ks) {
                    qe[tb][ks] = *(const GAS bf16x8*)(QE + ((tb * 4 + ks) * 64 + lane) * 8);
                    mw[tb][ks] = *(const GAS bf16x8*)(MW + ((tb * 4 + ks) * 64 + lane) * 8);
                }
            eL = SCb[c];
        };
        prefetch(0);
        N0 = ld_frag(NMb + (0 * 2 + db) * 1024, lane); N1 = ld_frag(NMb + (1 * 2 + db) * 1024, lane);
        if (layer == 0) { O0 = ld_frag(OLb + (0 * 2 + db) * 1024, lane); O1 = ld_frag(OLb + (1 * 2 + db) * 1024, lane); }
        for (int c = 0; c < NCHUNK; ++c) {
            const ChunkRows cr = chunk_rows(b, dir, c);
            const bool emit = (c >= 4 || layer == 0);
            const int cn = c + 1 < NCHUNK ? c + 1 : c;
            bf16x8 Sf[4];
            Sf[0] = acc_frag<0>(S0); Sf[1] = acc_frag<1>(S0); Sf[2] = acc_frag<0>(S1); Sf[3] = acc_frag<1>(S1);
#pragma unroll
            for (int g = 0; g < 16; ++g) { N0[g] += eL * S0[g]; N1[g] += eL * S1[g]; }
            if (c + 1 == 128) mixA_tail_wait(p, layer);
            const f32x16 Nq0 = ld_frag(NMb + (size_t)cn * 4096 + (0 * 2 + db) * 1024, lane), Nq1 = ld_frag(NMb + (size_t)cn * 4096 + (1 * 2 + db) * 1024, lane);
#pragma unroll
            for (int ks = 0; ks < 4; ++ks) { N0 = mfma32(mw[0][ks], Sf[ks], N0); N1 = mfma32(mw[1][ks], Sf[ks], N1); }
            if (emit) {
#pragma unroll
                for (int ks = 0; ks < 4; ++ks) { O0 = mfma32(qe[0][ks], Sf[ks], O0); O1 = mfma32(qe[1][ks], Sf[ks], O1); }
            }
            f32x16 Oq0 = {}, Oq1 = {};
            if (cn >= 4 || layer == 0) { Oq0 = ld_frag(OLb + (size_t)cn * 4096 + (0 * 2 + db) * 1024, lane); Oq1 = ld_frag(OLb + (size_t)cn * 4096 + (1 * 2 + db) * 1024, lane); }
            prefetch(cn);
            if (emit) {
#pragma unroll
                for (int tb = 0; tb < 2; ++tb) {
                    const f32x16& o = tb ? O1 : O0;
                    GAS float* orow = GDO + (size_t)(cr.r0 + cr.sgn * (32 * tb + 4 * hi)) * 256 + h * 64 + 32 * db + r_;
#pragma unroll
                    for (int g = 0; g < 16; ++g) orow[(ptrdiff_t)cr.sgn * (((g & 3) + 8 * (g >> 2)) * 256)] = o[g];
                }
            }
            S0 = N0; S1 = N1; N0 = Nq0; N1 = Nq1; O0 = Oq0; O1 = Oq1;
        }
    }
}

__device__ __forceinline__ void ph_finish(int wv, int layer) {
    const Params p = load_params();
    PHASE_IDS();
    const int tid = tid_, lane = tid & 63, wave = tid >> 6;
    const int gw = bid_ * 8 + wave, NGW = nblk_ * 8;
    const GAS bf16_t* P = (const GAS bf16_t*)(p.ws + OFF_PB);
    const GAS float* MLH = (const GAS float*)(p.ws + OFF_MLH); const GAS float* GDO = (const GAS float*)(p.ws + OFF_GDO);
    GAS bf16_t* Y = (GAS bf16_t*)(p.ws + OFF_Y);
    const int nrows = layer == 0 ? NROW : NLAT;
    const int c4 = 4 * lane;
    const f32x4 mg = *(const f32x4*)(p.in[I_MLOG] + layer * 256 + c4), gg = *(const f32x4*)(p.in[I_GOG] + layer * 64 + (c4 & 63));
    {
        const GAS bf16_t* PO = (const GAS bf16_t*)(p.ws + OFF_APO); const GAS float* AML = (const GAS float*)(p.ws + OFF_AML);
        for (int task = gw; task < ATT_NSU * 32; task += NGW) {
            const int s = task >> 5, rr = (task & 31) * 8 + (lane >> 3), fu = 512 - ATT_NSU + s, hd = (fu >> 5) & 7, orow = (fu >> 8) * SEQ + (fu & 31) * 256 + rr;
            u32x4 ov[3]; float m[3], l[3];
#pragma unroll
            for (int k = 0; k < 3; ++k) {
                const int combo = s * 3 + k;
                ov[k] = *(const GAS u32x4*)(PO + ((size_t)(combo >> 4) * 256 + rr) * DM + (combo & 15) * 64 + 8 * (lane & 7));
                const f32x2 ml = *(const GAS f32x2*)(AML + ((size_t)combo * 256 + rr) * 2);
                m[k] = ml.x; l[k] = ml.y;
            }
            const float M = fmaxf(fmaxf(m[0], m[1]), m[2]);
            float w[3], W = 0.f;
#pragma unroll
            for (int k = 0; k < 3; ++k) { w[k] = l[k] * __builtin_amdgcn_exp2f(m[k] - M); W += w[k]; }
            const float rW = 1.f / W;
            float acc[8];
#pragma unroll
            for (int j = 0; j < 8; ++j) acc[j] = 0.f;
#pragma unroll
            for (int k = 0; k < 3; ++k) {
                float f[8]; unpack8(ov[k], f);
                const float wk = w[k] * rW;
#pragma unroll
                for (int j = 0; j < 8; ++j) acc[j] += wk * f[j];
            }
            *(GAS u32x4*)(Y + (size_t)orow * DM + hd * 64 + 8 * (lane & 7)) = pack8(acc);
        }
    }
    for (int r = gw; r < nrows; r += NGW) {
        const f32x4 h0 = *(const GAS f32x4*)(MLH + (size_t)r * 256 + c4), h1 = *(const GAS f32x4*)(MLH + (size_t)NROW * 256 + (size_t)r * 256 + c4);
        const f32x4 g0 = *(const GAS f32x4*)(GDO + (size_t)r * 256 + c4), g1 = *(const GAS f32x4*)(GDO + (size_t)NROW * 256 + (size_t)r * 256 + c4);
        const u32x2 ow = *(const GAS u32x2*)(P + (size_t)r * NPC + 1536 + c4), zw = *(const GAS u32x2*)(P + (size_t)r * NPC + 2560 + c4);
        const f32x4 hs = h0 + h1, os = g0 + g1;
        float s1 = hs.x * hs.x + hs.y * hs.y + hs.z * hs.z + hs.w * hs.w, s2 = os.x * os.x + os.y * os.y + os.z * os.z + os.w * os.w;
        s1 += xor_lane<1>(s1); s1 += xor_lane<2>(s1); s1 += xor_lane<4>(s1); s1 += xor_lane<8>(s1);
        s2 += xor_lane<1>(s2); s2 += xor_lane<2>(s2); s2 += xor_lane<4>(s2); s2 += xor_lane<8>(s2);
        const float r1 = rsqrtf(s1 * (1.f / 64.f) + EPS), r2 = rsqrtf(s2 * (1.f / 64.f) + EPS);
        const float og[4] = {__uint_as_float(ow.x << 16), __uint_as_float(ow.x & 0xffff0000u), __uint_as_float(ow.y << 16), __uint_as_float(ow.y & 0xffff0000u)};
        const float zg[4] = {__uint_as_float(zw.x << 16), __uint_as_float(zw.x & 0xffff0000u), __uint_as_float(zw.y << 16), __uint_as_float(zw.y & 0xffff0000u)};
        float ym[4], yg[4];
#pragma unroll
        for (int i = 0; i < 4; ++i) { ym[i] = sigmoidf_(og[i]) * hs[i] * r1 * mg[i]; yg[i] = os[i] * r2 * gg[i] * siluf(zg[i]); }
        u32x2 o; o.x = pk_bf16(ym[0], ym[1]); o.y = pk_bf16(ym[2], ym[3]);
        *(GAS u32x2*)(Y + (size_t)r * DM + 512 + c4) = o;
        o.x = pk_bf16(yg[0], yg[1]); o.y = pk_bf16(yg[2], yg[3]);
        *(GAS u32x2*)(Y + (size_t)r * DM + 768 + c4) = o;
    }
}

__device__ __forceinline__ void ph_route(int wv, int layer) {
    const Params p = load_params();
    PHASE_IDS();
    const int tid = tid_, lane = tid & 63, wave = tid >> 6;
    const int gw = bid_ * 8 + wave, NGW = nblk_ * 8;
    const float* MODV = (const float*)(p.ws + OFF_MODV) + (size_t)layer * 3 * NMOD;
    const float* ng = p.in[I_N2G] + (size_t)layer * DM;
    const float* X1 = (const float*)(p.ws + OFF_X1);
    GAS bf16_t* H2 = (GAS bf16_t*)(p.ws + OFF_XA);
    const GAS bf16_t* RWt = (const GAS bf16_t*)(p.ws + OFF_RWT) + (size_t)layer * NE * DM;
    GAS float* AFF = (GAS float*)(p.ws + OFF_AFF);
    const int nrows = layer == 0 ? NROW : NLAT;
    for (int task = wave * nblk_ + bid_; task < nrows / 16; task += NGW) {
        const int row0 = task * 16;
        const float* mv = MODV + (size_t)row_sel(row0) * NMOD;
        f32x4 ga[4], sh[4];
#pragma unroll
        for (int j = 0; j < 4; ++j) {
            const int col = 4 * lane + 256 * j;
            const f32x4 g = *(const f32x4*)(ng + col), sc = *(const f32x4*)(mv + 4 * DM + col);
            sh[j] = *(const f32x4*)(mv + 3 * DM + col);
            ga[j] = g * (sc + (f32x4){1.f, 1.f, 1.f, 1.f});
        }
#pragma unroll 1
        for (int rb = 0; rb < 16; rb += 4) {
            f32x4 v[4][4];
#pragma unroll
            for (int q = 0; q < 4; ++q) {
                const float* xr = X1 + (size_t)(row0 + rb + q) * DM;
#pragma unroll
                for (int j = 0; j < 4; ++j) v[q][j] = *(const f32x4*)(xr + 4 * lane + 256 * j);
            }
#pragma unroll
            for (int q = 0; q < 4; ++q) {
                float ss = 0.f;
#pragma unroll
                for (int j = 0; j < 4; ++j) ss += v[q][j].x * v[q][j].x + v[q][j].y * v[q][j].y + v[q][j].z * v[q][j].z + v[q][j].w * v[q][j].w;
                const float rstd = rsqrtf(wave_sum(ss) * (1.f / DM) + EPS);
#pragma unroll
                for (int j = 0; j < 4; ++j) {
                    const f32x4 h = v[q][j] * rstd * ga[j] + sh[j];
                    u32x2 o; o.x = pk_bf16(h.x, h.y); o.y = pk_bf16(h.z, h.w);
                    *(GAS u32x2*)(H2 + (size_t)(row0 + rb + q) * DM + 4 * lane + 256 * j) = o;
                }
            }
        }
        __builtin_amdgcn_fence(__ATOMIC_RELEASE, "workgroup"); __builtin_amdgcn_fence(__ATOMIC_ACQUIRE, "workgroup");
        f32x4 acc[1];
        skinny_proj<1>(H2 + (size_t)row0 * DM, RWt, lane, acc);
#pragma unroll
        for (int i = 0; i < 4; ++i) {
            float mx = acc[0][i];
            mx = fmaxf(mx, xor_lane<1>(mx)); mx = fmaxf(mx, xor_lane<2>(mx)); mx = fmaxf(mx, xor_lane<4>(mx)); mx = fmaxf(mx, xor_lane<8>(mx));
            const float ex = expf(acc[0][i] - mx);
            float se = ex;
            se += xor_lane<1>(se); se += xor_lane<2>(se); se += xor_lane<4>(se); se += xor_lane<8>(se);
            AFF[(size_t)(row0 + 4 * (lane >> 4) + i) * NE + (lane & 15)] = ex / se;
        }
    }
}

__device__ __forceinline__ void ph_topk(int wv, int layer, LAS unsigned char* lds) {
    const Params p = load_params();
    int wv_ = __builtin_amdgcn_readfirstlane(wv); asm volatile("" : "+s"(wv_)); int tid_; { int l_; asm volatile("v_mbcnt_lo_u32_b32 %0, -1, 0\n\tv_mbcnt_hi_u32_b32 %0, -1, %0" : "=v"(l_)); tid_ = wv_ * 64 + l_; } int bid_ = blockIdx.x; asm volatile("" : "+s"(bid_)); int nblk_ = gridDim.x; asm volatile("" : "+s"(nblk_));
    const int tid = tid_, lane = tid & 63, wave = tid >> 6;
    LAS unsigned* keys = (LAS unsigned*)lds;
    LAS unsigned* hist = keys + 8192;
    LAS unsigned* sh = hist + 256;
    const float* AFF = (const float*)(p.ws + OFF_AFF);
    int* IDX = (int*)(p.ws + OFF_IDX); float* VALS = (float*)(p.ws + OFF_VALS); int* SLOT = (int*)(p.ws + OFF_SLOT);
    const int nprob = layer == 0 ? 64 : 32;
    for (int pr = bid_; pr < nprob; pr += nblk_) {
        const bool isctx = pr >= 32; const int q = pr & 31, b = q >> 4, e = q & 15;
        const int N = isctx ? CTXL : SEQ, cap = isctx ? CAPC : CAPL, row0 = isctx ? NLAT + b * CTXL : b * SEQ;
        for (int n = tid; n < N; n += 512) keys[n] = __float_as_uint(AFF[(size_t)(row0 + n) * NE + e]);
        unsigned prefix = 0, need = (unsigned)cap;
        for (int pass = 0; pass < 4; ++pass) {
            const int shift = 24 - 8 * pass;
            if (tid < 256) hist[tid] = 0;
            __syncthreads();
            for (int n = tid; n < N; n += 512) {
                const unsigned k = keys[n];
                if (pass == 0 || (k >> (shift + 8)) == (prefix >> (shift + 8))) atomicAdd((unsigned*)&hist[(k >> shift) & 255u], 1u);
            }
            __syncthreads();
            if (wave == 0) {
                const unsigned c0 = hist[4 * lane], c1 = hist[4 * lane + 1], c2 = hist[4 * lane + 2], c3 = hist[4 * lane + 3];
                const unsigned mine = c0 + c1 + c2 + c3;
                unsigned suf = mine;
#pragma unroll
                for (int o = 1; o < 64; o <<= 1) { const unsigned t = (unsigned)__builtin_amdgcn_ds_bpermute((lane + o) << 2, (int)suf); if (lane + o < 64) suf += t; }
                const unsigned above = suf - mine;
                if (above < need && suf >= need) {
                    unsigned cum = above; int bin = 4 * lane + 3;
                    if (cum + c3 >= need) bin = 4 * lane + 3;
                    else { cum += c3; if (cum + c2 >= need) bin = 4 * lane + 2; else { cum += c2; if (cum + c1 >= need) bin = 4 * lane + 1; else { cum += c1; bin = 4 * lane; } } }
                    sh[0] = prefix | ((unsigned)bin << shift); sh[1] = need - cum;
                }
            }
            __syncthreads();
            prefix = sh[0]; need = sh[1];
            __syncthreads();
        }
        const unsigned T = prefix, need_eq = need;
        const int per = (N + 511) / 512, n0 = tid * per, n1 = min(N, n0 + per);
        unsigned cgt = 0, ceq = 0;
        for (int n = n0; n < n1; ++n) { const unsigned k = keys[n]; cgt += (k > T); ceq += (k == T); }
        unsigned igt = cgt, ieq = ceq;
#pragma unroll
        for (int o = 1; o < 64; o <<= 1) { const unsigned a = (unsigned)__builtin_amdgcn_ds_bpermute((lane - o) << 2, (int)igt), c = (unsigned)__builtin_amdgcn_ds_bpermute((lane - o) << 2, (int)ieq); if (lane >= o) { igt += a; ieq += c; } }
        if (lane == 63) { sh[16 + wave] = igt; sh[32 + wave] = ieq; }
        __syncthreads();
        unsigned bgt = igt - cgt, beq = ieq - ceq;
        for (int w = 0; w < wave; ++w) { bgt += sh[16 + w]; beq += sh[32 + w]; }
        for (int n = n0; n < n1; ++n) {
            const unsigned k = keys[n];
            const bool sel = (k > T) || (k == T && beq < need_eq);
            const unsigned slot = bgt + min(beq, need_eq);
            if (sel) {
                const int hr = isctx ? NB * NE * CAPL + (e * 2 + b) * CAPC + (int)slot : (e * 2 + b) * CAPL + (int)slot;
                IDX[hr] = row0 + n; VALS[hr] = __uint_as_float(k);
                SLOT[(size_t)e * NROW + row0 + n] = (int)slot;
            } else SLOT[(size_t)e * NROW + row0 + n] = -1;
            bgt += (k > T); beq += (k == T);
        }
        __syncthreads();
    }
}

__device__ __forceinline__ void ph_combine(int wv, int layer) {
    const Params p = load_params();
    PHASE_IDS();
    const int tid = tid_, lane = tid & 63, wave = tid >> 6;
    const int gw = bid_ * 8 + wave, NGW = nblk_ * 8;
    const float* MODV = (const float*)(p.ws + OFF_MODV) + (size_t)layer * 3 * NMOD;
    const GAS float* X1 = (const GAS float*)(p.ws + OFF_X1); const GAS bf16_t* YE = (const GAS bf16_t*)(p.ws + OFF_YE);
    const GAS int* SLOT = (const GAS int*)(p.ws + OFF_SLOT);
    const int nrows = layer == 0 ? NROW : NLAT;
    for (int r = gw; r < nrows; r += NGW) {
        const bool lat = r < NLAT;
        const int b = lat ? (r >> 13) : ((r - NLAT) >> 8);
        const float* g2 = MODV + (size_t)row_sel(r) * NMOD + 5 * DM;
        const int myslot = lane < NE ? SLOT[(size_t)lane * NROW + r] : -1;
        unsigned long long mask = __ballot(myslot >= 0);
        f32x4 xv[4];
#pragma unroll
        for (int j = 0; j < 4; ++j) xv[j] = *(const GAS f32x4*)(X1 + (size_t)r * DM + 4 * lane + 256 * j);
        f32x4 acc[4];
#pragma unroll
        for (int j = 0; j < 4; ++j) acc[j] = (f32x4){0.f, 0.f, 0.f, 0.f};
        while (mask) {
            const int e = __builtin_ctzll(mask); mask &= mask - 1;
            const int s = __builtin_amdgcn_readlane(myslot, e);
            const int nq = lat ? 1 : 4;
            const GAS bf16_t* yr = lat ? YE + (size_t)((e * 2 + b) * CAPL + s) * DM : (const GAS bf16_t*)(p.ws + OFF_YEC) + (size_t)((e * 2 + b) * CAPC + s) * DM;
            for (int q = 0; q < nq; ++q) {
#pragma unroll
                for (int j = 0; j < 4; ++j) {
                    const u32x2 w = *(const GAS u32x2*)(yr + (size_t)q * 1024 * DM + 4 * lane + 256 * j);
                    acc[j] += (f32x4){__uint_as_float(w.x << 16), __uint_as_float(w.x & 0xffff0000u), __uint_as_float(w.y << 16), __uint_as_float(w.y & 0xffff0000u)};
                }
            }
        }
        float* orow = layer == 0 ? (float*)(p.ws + OFF_X2) + (size_t)r * DM : p.out + (size_t)r * DM;
#pragma unroll
        for (int j = 0; j < 4; ++j) {
            const int col = 4 * lane + 256 * j;
            const f32x4 gv = *(const f32x4*)(g2 + col);
            *(f32x4*)(orow + col) = xv[j] + gv * acc[j];
        }
    }
}

__device__ __forceinline__ void xcd_barrier_post(int wv, LAS unsigned char* lds) {
    const Params p = load_params();
    PHASE_IDS();
    volatile LAS unsigned* st = (volatile LAS unsigned*)(lds + LDS_MAIN);
    if (tid_ == 0) { st[0] = 0u; st[1] = 0u; (void)xb_add(&((unsigned*)(p.ws + OFF_BAR))[XB_XCNT(xb_xcc_id())], 1u); }
    __syncthreads();
    (void)bid_; (void)nblk_;
}
__device__ __forceinline__ void xcd_barrier_complete(unsigned* bar, unsigned x, unsigned G, unsigned& nloc, unsigned& nx) {
    unsigned sum, cnt, mine, sp = 0u;
    for (;;) {
        sum = 0u; cnt = 0u; mine = 0u;
#pragma unroll
        for (unsigned j = 0; j < 16; ++j) { const unsigned c = xb_ld(&bar[XB_XCNT(j)]); sum += c; cnt += (c > 0u) ? 1u : 0u; mine = (j == x) ? c : mine; }
        if (sum == G) break;
        __builtin_amdgcn_s_sleep(1);
        if ((++sp & 255u) == 0u) { if (xb_ld(&bar[XB_TMO])) break; if (sp > XB_SPIN_CAP) { atomicAdd(&bar[XB_TMO], 1u); break; } }
    }
    nloc = mine > 0u ? mine : 1u; nx = cnt > 0u ? cnt : 1u;
}
__device__ __forceinline__ void grid_barrier(int wv, LAS unsigned char* lds) {
    const Params p = load_params();
    PHASE_IDS();
    asm volatile("s_waitcnt vmcnt(0)" ::: "memory");
    __syncthreads();
    if (tid_ == 0) {
        unsigned* bar = (unsigned*)(p.ws + OFF_BAR);
        volatile LAS unsigned* st = (volatile LAS unsigned*)(lds + LDS_MAIN);
        const unsigned x = xb_xcc_id();
        __builtin_amdgcn_s_waitcnt(0);
        unsigned nloc = st[0], nx = st[1];
        if (nloc == 0u) { xcd_barrier_complete(bar, x, (unsigned)nblk_, nloc, nx); st[0] = nloc; st[1] = nx; }
        const unsigned old = xb_add(&bar[XB_XSUB(x)], 1u);
        const unsigned gen = old / nloc;
        if (old + 1u == (gen + 1u) * nloc) {
            __builtin_amdgcn_fence(__ATOMIC_RELEASE, "agent");
            asm volatile("s_waitcnt vmcnt(0)" ::: "memory");
            const unsigned og = xb_add(&bar[XB_TOP], 1u);
            const unsigned tg = og / nx;
            if (og + 1u == (tg + 1u) * nx) xb_add(&bar[XB_TOPGEN], 1u);
            else XB_SPIN(xb_ld(&bar[XB_TOPGEN]) == tg, bar);
            __builtin_amdgcn_fence(__ATOMIC_ACQUIRE, "agent");
            xb_add(&bar[XB_XGEN(x)], 1u);
            asm volatile("s_waitcnt vmcnt(0)" ::: "memory");
        } else {
            XB_SPIN(xb_ld(&bar[XB_XGEN(x)]) == gen, bar);
            __builtin_amdgcn_fence(__ATOMIC_ACQUIRE, "agent");
            asm volatile("s_waitcnt vmcnt(0)" ::: "memory");
        }
    }
    __syncthreads();
    (void)bid_;
}

#ifndef PHMASK
#define PHMASK 0xffff
#endif
#define PHON(i) ((PHMASK >> (i)) & 1)
#ifndef DUP_MASK
#define DUP_MASK 0u
#endif
#define PH(i, call) do { if (PHON(i)) { call; if ((DUP_MASK >> (i)) & 1u) { int nrep_ = 8; asm volatile("" : "+s"(nrep_)); for (int k_ = 0; k_ < nrep_; ++k_) { __syncthreads(); call; } } } } while (0)
template <int layer> __device__ __forceinline__ void run_layer(const int wv, LAS unsigned char* lds, cooperative_groups::grid_group& grid) {
        PH(2, ph_norm1(wv, layer));
        grid_barrier(wv, lds);
        PH(3, ph_gemm_in(wv, layer, lds));
        grid_barrier(wv, lds);
        PH(4, ph_prep(wv, layer));
        grid_barrier(wv, lds);
        PH(6, ph_mixA<0>(wv, layer, lds));
        grid_barrier(wv, lds);
        PH(15, ph_mixA<1>(wv, layer, lds));
        __syncthreads();
        PH(14, ph_mixB(wv, layer, lds));
        PH(5, ph_attn(wv, layer, lds));
        grid_barrier(wv, lds);
        PH(7, ph_finish(wv, layer));
        grid_barrier(wv, lds);
        PH(8, ph_gemm_out(wv, layer, lds));
        grid_barrier(wv, lds);
        PH(9, ph_route(wv, layer));
        grid_barrier(wv, lds);
        PH(10, ph_topk(wv, layer, lds));
        grid_barrier(wv, lds);
        PH(11, ph_moe1(wv, layer, lds));
        grid_barrier(wv, lds);
        PH(12, ph_moe2(wv, layer, lds));
        grid_barrier(wv, lds);
        PH(13, ph_combine(wv, layer));
        if (layer == 0) grid_barrier(wv, lds);}

namespace cg = cooperative_groups;
__global__ void __launch_bounds__(512) fwd_mega(Params p) {
    extern __shared__ __attribute__((aligned(16))) unsigned char lds_raw[];
    LAS unsigned char* lds = (LAS unsigned char*)lds_raw;
    cg::grid_group grid = cg::this_grid();
    const int wv = __builtin_amdgcn_readfirstlane((int)(threadIdx.x >> 6));
    xcd_barrier_post(wv, lds);
    PH(0, ph_convert(wv, lds));
    __syncthreads();
    PH(1, ph_mod(wv, lds));
    grid.sync();
    run_layer<0>(wv, lds, grid);
    run_layer<1>(wv, lds, grid);
}

extern "C" void kernel_launch(void* const* d_in, const int* in_sizes, int n_in, void* d_out, int out_size, void* d_ws, size_t ws_size, hipStream_t stream) {
    static int grid_blocks = 0;
    if (grid_blocks == 0) {
        grid_blocks = -1;
        int dev = 0, cus = 0, per_cu = 0;
        if (n_in != 23 || ws_size < WS_NEED) { fprintf(stderr, "kernel_launch: unexpected n_in %d / ws_size %zu (need %zu)\n", n_in, ws_size, (size_t)WS_NEED); return; }
        if (hipFuncSetAttribute((const void*)fwd_mega, hipFuncAttributeMaxDynamicSharedMemorySize, LDS_BYTES) != hipSuccess) { fprintf(stderr, "kernel_launch: hipFuncSetAttribute failed\n"); return; }
        if (hipGetDevice(&dev) != hipSuccess || hipDeviceGetAttribute(&cus, hipDeviceAttributeMultiprocessorCount, dev) != hipSuccess) { fprintf(stderr, "kernel_launch: device query failed\n"); return; }
        if (hipOccupancyMaxActiveBlocksPerMultiprocessor(&per_cu, (const void*)fwd_mega, 512, LDS_BYTES) != hipSuccess || per_cu < 1) { fprintf(stderr, "kernel_launch: occupancy query failed (%d)\n", per_cu); return; }
        grid_blocks = cus * 1;
        fprintf(stderr, "kernel_launch: cus %d per_cu %d grid %d\n", cus, per_cu, grid_blocks);
    }
    if (grid_blocks < 0) return;
    Params p{};
    for (int i = 0; i < 23; ++i) p.in[i] = (const float*)d_in[i];
    p.out = (float*)d_out; p.ws = (unsigned char*)d_ws; p.phase = -1; p.layer = 0;
    if (hipMemsetAsync((char*)d_ws + OFF_CTL, 0, CTL_BYTES, stream) != hipSuccess) { fprintf(stderr, "kernel_launch: memset of control words failed\n"); return; }
    void* args[] = {&p};
    hipError_t e = hipLaunchCooperativeKernel((const void*)fwd_mega, dim3(grid_blocks), dim3(512), args, LDS_BYTES, stream);
    if (e != hipSuccess) fprintf(stderr, "cooperative launch failed: %s (grid %d)\n", hipGetErrorString(e), grid_blocks);
}
```

```cpp
#include <hip/hip_runtime.h>
#include <hip/hip_cooperative_groups.h>
#include <hip/hip_bf16.h>
#include <cmath>
#include <stdint.h>
#include <stdio.h>

#define LAS __attribute__((address_space(3)))
#define GAS __attribute__((address_space(1)))
typedef unsigned short bf16_t;
typedef short bf16x8 __attribute__((ext_vector_type(8)));
typedef short s16x4 __attribute__((ext_vector_type(4)));
typedef float f32x4 __attribute__((ext_vector_type(4)));
typedef float f32x16 __attribute__((ext_vector_type(16)));
typedef float f32x2 __attribute__((ext_vector_type(2)));
typedef __bf16 bf16x2_t __attribute__((ext_vector_type(2)));
typedef unsigned u32x4 __attribute__((ext_vector_type(4)));
typedef unsigned u32x2 __attribute__((ext_vector_type(2)));

constexpr int NB = 2, SEQ = 8192, DM = 1024, CTXL = 256;
constexpr int NLAT = NB * SEQ, NCTX = NB * CTXL, NROW = NLAT + NCTX;
constexpr int NPC = 2816, NGC = 32, INW = 2848;
constexpr int NE = 16, FF = 2048, CAPL = 1024, CAPC = 32;
constexpr int KPOS = CTXL + SEQ;
constexpr int NMOD = 6 * DM;
constexpr int NHIDROW = NB * NE * CAPL + NB * NE * CAPC;
constexpr float EPS = 1e-6f;
constexpr float QSCALE = 0.125f * 1.4426950408889634f;

constexpr size_t MiB = 1u << 20;
constexpr size_t OFF_CTL = 0;
constexpr size_t OFF_MODV = 1 * MiB;
constexpr size_t OFF_WG = OFF_MODV + 256 * 1024;
constexpr size_t OFF_RWT = OFF_WG + 128 * 1024;
constexpr size_t OFF_ROPE = OFF_RWT + 64 * 1024;
constexpr size_t OFF_WTIN = 2 * MiB;
constexpr size_t OFF_WTOUT = 14 * MiB;
constexpr size_t OFF_WT13 = 18 * MiB;
constexpr size_t OFF_WT2 = 274 * MiB;
constexpr size_t OFF_X1 = 402 * MiB;
constexpr int ATT_NSU = 80;
constexpr size_t OFF_APO = OFF_X1;
constexpr size_t OFF_AML = OFF_X1 + 16 * MiB;
constexpr size_t OFF_X2 = 468 * MiB;
constexpr size_t OFF_XA = 534 * MiB;
constexpr size_t OFF_Y = 567 * MiB;
constexpr size_t OFF_AFF = 600 * MiB;
constexpr size_t OFF_IDX = 602 * MiB;
constexpr size_t OFF_VALS = 603 * MiB;
constexpr size_t OFF_SLOT = 604 * MiB;
constexpr size_t OFF_S0 = 606 * MiB;
constexpr size_t OFF_PB = OFF_S0;
constexpr size_t OFF_G = OFF_S0 + 92 * MiB;
constexpr size_t OFF_QB = OFF_S0 + 95 * MiB;
constexpr size_t OFF_KB = OFF_S0 + 112 * MiB;
constexpr size_t OFF_VT = OFF_S0 + 117 * MiB;
constexpr size_t OFF_MLH = OFF_S0 + 122 * MiB;
constexpr size_t OFF_GDO = OFF_S0 + 155 * MiB;
constexpr size_t OFF_GQB = OFF_S0 + 188 * MiB;
constexpr size_t OFF_GKB = OFF_S0 + 197 * MiB;
constexpr size_t OFF_GVB = OFF_S0 + 206 * MiB;
constexpr int NCHUNK = KPOS / 64;
constexpr int NUNIT = 16 * NCHUNK;
constexpr size_t OFF_MLNUM = OFF_S0 + 215 * MiB;
constexpr size_t OFF_MLKL = OFF_S0 + 248 * MiB;
constexpr size_t OFF_MLVEC = OFF_S0 + 281 * MiB;
constexpr size_t OFF_GDMW = OFF_S0 + 284 * MiB;
constexpr size_t OFF_GDN = OFF_S0 + 301 * MiB;
constexpr size_t OFF_GDQE = OFF_S0 + 334 * MiB;
constexpr size_t OFF_GDOL = OFF_S0 + 351 * MiB;
constexpr size_t OFF_GDSC = OFF_S0 + 384 * MiB;
constexpr size_t OFF_HID = OFF_S0;
constexpr size_t OFF_YE = OFF_S0 + 132 * MiB;
constexpr size_t OFF_YEC = OFF_S0 + 200 * MiB;
constexpr size_t OFF_XPC = OFF_S0 + 208 * MiB;
constexpr size_t OFF_MLQP = OFF_S0 + 385 * MiB;
constexpr size_t WS_NEED = OFF_S0 + 402 * MiB;

constexpr int LDS_MAIN = 8 * 18176;
constexpr int LDS_BYTES = LDS_MAIN + 16;
constexpr int CTL_BYTES = 32768;

struct Params {
    const float* in[23];
    float* out;
    unsigned char* ws;
    int phase, layer;
};
enum { I_X = 0, I_C, I_CTX, I_CCTX, I_MODW, I_MODB, I_N1G, I_WIN, I_QNG, I_KNG, I_MLIB, I_MLFB, I_MLOG, I_GCW, I_GAL, I_GDT, I_GOG, I_WOUT, I_N2G, I_RW, I_W1, I_W3, I_W2 };

typedef const __attribute__((address_space(4))) Params* KParams;
__device__ __forceinline__ Params load_params() {
    Params r{};
#if defined(__HIP_DEVICE_COMPILE__)
    const __attribute__((address_space(4))) unsigned long long* s = (const __attribute__((address_space(4))) unsigned long long*)__builtin_amdgcn_kernarg_segment_ptr();
    asm volatile("" : "+s"(s));
    unsigned long long* d = (unsigned long long*)&r;
#pragma unroll
    for (unsigned i = 0; i < sizeof(Params) / 8; ++i) d[i] = s[i];
#endif
    return r;
}

#define PHASE_IDS() int wv_ = __builtin_amdgcn_readfirstlane(wv); asm volatile("" : "+s"(wv_)); int tid_; { int l_; asm volatile("v_mbcnt_lo_u32_b32 %0, -1, 0\n\tv_mbcnt_hi_u32_b32 %0, -1, %0" : "=v"(l_)); tid_ = wv_ * 64 + l_; } int bid_ = blockIdx.x; asm volatile("" : "+s"(bid_)); int nblk_ = gridDim.x; asm volatile("" : "+s"(nblk_));
__device__ __forceinline__ unsigned pk_bf16(float lo, float hi) { f32x2 v = {lo, hi}; bf16x2_t b = __builtin_convertvector(v, bf16x2_t); return __builtin_bit_cast(unsigned, b); }
template <int K> __device__ __forceinline__ float xor_lane(float v) {
    if constexpr (K == 32) { auto rr = __builtin_amdgcn_permlane32_swap(__builtin_bit_cast(unsigned, v), __builtin_bit_cast(unsigned, v), false, false);
        const unsigned lo = rr[0], hi = rr[1]; const unsigned own = __builtin_bit_cast(unsigned, v);
        return __builtin_bit_cast(float, (lo ^ hi) ^ own); }
    else if constexpr (K == 1) return __builtin_bit_cast(float, __builtin_amdgcn_update_dpp(0, __builtin_bit_cast(int, v), 0xB1, 0xF, 0xF, true));
    else if constexpr (K == 2) return __builtin_bit_cast(float, __builtin_amdgcn_update_dpp(0, __builtin_bit_cast(int, v), 0x4E, 0xF, 0xF, true));
    else return __builtin_bit_cast(float, __builtin_amdgcn_ds_swizzle(__builtin_bit_cast(int, v), (K << 10) | 0x1f));
}
__device__ __forceinline__ float dpp_hmirror(float v) { return __builtin_bit_cast(float, __builtin_amdgcn_update_dpp(0, __builtin_bit_cast(int, v), 0x141, 0xF, 0xF, true)); }
__device__ __forceinline__ float dpp_mirror(float v) { return __builtin_bit_cast(float, __builtin_amdgcn_update_dpp(0, __builtin_bit_cast(int, v), 0x140, 0xF, 0xF, true)); }
__device__ __forceinline__ float wave_sum(float v) {
    v += xor_lane<1>(v); v += xor_lane<2>(v); v += xor_lane<4>(v); v += xor_lane<8>(v); v += xor_lane<16>(v); v += xor_lane<32>(v);
    return v;
}
__device__ __forceinline__ float siluf(float x) { return x / (1.f + expf(-x)); }
__device__ __forceinline__ float fsilu(float x) { return x * __builtin_amdgcn_rcpf(1.f + __builtin_amdgcn_exp2f(-1.4426950408889634f * x)); }
__device__ __forceinline__ float sigmoidf_(float x) { return 1.f / (1.f + expf(-x)); }
__device__ __forceinline__ float softplusf_(float x) { return fmaxf(x, 0.f) + log1pf(expf(-fabsf(x))); }
__device__ __forceinline__ float logsigmoidf_(float x) { return fminf(x, 0.f) - log1pf(expf(-fabsf(x))); }
__device__ __forceinline__ float bf2f(bf16_t v) { return __uint_as_float((unsigned)v << 16); }
__device__ __forceinline__ bf16_t f2bf(float v) { return (bf16_t)(pk_bf16(v, 0.f) & 0xffffu); }
__device__ __forceinline__ float rdlane(float v, int l) { return __builtin_bit_cast(float, __builtin_amdgcn_readlane(__builtin_bit_cast(int, v), l)); }

__device__ __forceinline__ f32x4 ld4_bf16(const bf16_t* q) { const u32x2 w = *(const u32x2*)q; return (f32x4){__uint_as_float(w.x << 16), __uint_as_float(w.x & 0xffff0000u), __uint_as_float(w.y << 16), __uint_as_float(w.y & 0xffff0000u)}; }
__device__ __forceinline__ void st4_bf16(bf16_t* q, const f32x4 v) { u32x2 o; o.x = pk_bf16(v.x, v.y); o.y = pk_bf16(v.z, v.w); *(u32x2*)q = o; }
__device__ __forceinline__ f32x4 xin4(const Params& p, int layer, int r, int col) {
    if (layer == 0) return *(const f32x4*)((r < NLAT ? p.in[I_X] + (size_t)r * DM : p.in[I_CTX] + (size_t)(r - NLAT) * DM) + col);
    return ld4_bf16((const bf16_t*)(p.ws + OFF_X2) + (size_t)r * DM + col);
}
__device__ __forceinline__ int row_sel(int r) { return r < NLAT ? (r >> 13) : 2; }

#define XB_TMO      128
#define XB_XCNT(j)  (256  + 64 * (j))
#define XB_XSUB(j)  (1280 + 64 * (j))
#define XB_XGEN(j)  (2304 + 64 * (j))
#define XB_TOP      3328
#define XB_TOPGEN   3392
#define XCD_BAR_WORDS 3456
#define XB_SPIN_CAP (1u << 20)
constexpr size_t OFF_BAR = OFF_CTL + 4096;
__device__ __forceinline__ unsigned xb_ld(unsigned* p)              { return __hip_atomic_load(p, __ATOMIC_RELAXED, __HIP_MEMORY_SCOPE_AGENT); }
__device__ __forceinline__ unsigned xb_add(unsigned* p, unsigned v) { return __hip_atomic_fetch_add(p, v, __ATOMIC_RELAXED, __HIP_MEMORY_SCOPE_AGENT); }
__device__ __forceinline__ unsigned xb_xcc_id() { return (unsigned)__builtin_amdgcn_s_getreg((3 << 11) | 20) & 0xFu; }
#define XB_SPIN(cond, bar) do { unsigned _sp = 0; while (cond) { __builtin_amdgcn_s_sleep(1); \
    if ((++_sp & 255u) == 0u) { if (xb_ld(&(bar)[XB_TMO])) break; if (_sp > XB_SPIN_CAP) { atomicAdd(&(bar)[XB_TMO], 1u); break; } } } } while (0)

template <class RowMap>
__device__ __forceinline__ void transpose_item(const float* W, int N, int k0, int n0, bf16_t* WT, int K, LAS float* scr, int lane, RowMap rowmap) {
    {
        const int nn = (lane & 15) * 4;
        const float* src = W + (size_t)(k0 + (lane >> 4)) * N + n0 + nn;
        f32x4 v[16];
#pragma unroll
        for (int i = 0; i < 16; ++i) v[i] = __builtin_nontemporal_load((const f32x4*)(src + (size_t)(4 * i) * N));
#pragma unroll
        for (int i = 0; i < 16; ++i) { LAS float* s = scr + (4 * i + (lane >> 4)) * 65 + nn; s[0] = v[i].x; s[1] = v[i].y; s[2] = v[i].z; s[3] = v[i].w; }
    }
    asm volatile("s_waitcnt lgkmcnt(0)" ::: "memory");
    const int c = lane & 7;
#pragma unroll
    for (int j = 0; j < 8; ++j) {
        const int n = (lane >> 3) + 8 * j; const LAS float* s = scr + (8 * c) * 65 + n;
        u32x4 o; o.x = pk_bf16(s[0 * 65], s[1 * 65]); o.y = pk_bf16(s[2 * 65], s[3 * 65]); o.z = pk_bf16(s[4 * 65], s[5 * 65]); o.w = pk_bf16(s[6 * 65], s[7 * 65]);
        const int orow = rowmap(n0 + n);
        if (orow >= 0) __builtin_nontemporal_store(o, (u32x4*)(WT + (size_t)orow * K + k0 + 8 * c));
    }
    asm volatile("s_waitcnt lgkmcnt(0)" ::: "memory");
}
__device__ __forceinline__ void ph_convert(int wv, LAS unsigned char* lds) {
    const Params p = load_params();
    PHASE_IDS();
    const int tid = tid_, lane = tid & 63, wave = tid >> 6;
    LAS float* scr = (LAS float*)(lds + wave * 16640);
    const int gw = bid_ * 8 + wave, NGW = nblk_ * 8;
    constexpr int I_IN = 16 * 45, I_OUT = 16 * 16, I_E = 512, PER_LAYER = I_IN + I_OUT + 3 * NE * I_E;
    for (int it = gw; it < 2 * PER_LAYER; it += NGW) {
        const int l = it / PER_LAYER; int r = it % PER_LAYER;
        if (r < I_IN) {
            const int kb = r / 45, nb = r % 45;
            const int n0 = nb < 44 ? nb * 64 : INW - 64;
            transpose_item(p.in[I_WIN] + (size_t)l * DM * INW, INW, kb * 64, n0, (bf16_t*)(p.ws + OFF_WTIN) + (size_t)l * NPC * DM, DM, scr, lane,
                           [](int c) { return c < 1792 ? c : (c < 1808 ? -1 : (c < 2832 ? c - 16 : -1)); });
            continue;
        }
        r -= I_IN;
        if (r < I_OUT) {
            const int kb = r / 16, nb = r % 16;
            transpose_item(p.in[I_WOUT] + (size_t)l * DM * DM, DM, kb * 64, nb * 64, (bf16_t*)(p.ws + OFF_WTOUT) + (size_t)l * DM * DM, DM, scr, lane, [](int c) { return c; });
            continue;
        }
        r -= I_OUT;
        if (r < NE * I_E) {
            const int e = r / I_E, rr = r % I_E, kb = rr / 32, nb = rr % 32;
            transpose_item(p.in[I_W1] + ((size_t)l * NE + e) * DM * FF, FF, kb * 64, nb * 64, (bf16_t*)(p.ws + OFF_WT13) + ((size_t)l * NE + e) * 4096 * DM, DM, scr, lane,
                           [](int f) { return (f >> 7) * 256 + (f & 127); });
            continue;
        }
        r -= NE * I_E;
        if (r < NE * I_E) {
            const int e = r / I_E, rr = r % I_E, kb = rr / 32, nb = rr % 32;
            transpose_item(p.in[I_W3] + ((size_t)l * NE + e) * DM * FF, FF, kb * 64, nb * 64, (bf16_t*)(p.ws + OFF_WT13) + ((size_t)l * NE + e) * 4096 * DM, DM, scr, lane,
                           [](int f) { return (f >> 7) * 256 + 128 + (f & 127); });
            continue;
        }
        r -= NE * I_E;
        {
            const int e = r / I_E, rr = r % I_E, kb = rr / 16, nb = rr % 16;
            transpose_item(p.in[I_W2] + ((size_t)l * NE + e) * FF * DM, DM, kb * 64, nb * 64, (bf16_t*)(p.ws + OFF_WT2) + ((size_t)l * NE + e) * DM * FF, FF, scr, lane, [](int c) { return c; });
        }
    }
    bf16_t* WGt = (bf16_t*)(p.ws + OFF_WG); bf16_t* RWt = (bf16_t*)(p.ws + OFF_RWT);
    for (int i = bid_ * 512 + tid; i < 2 * NGC * DM; i += nblk_ * 512) {
        const int l = i / (NGC * DM), j = (i / DM) % NGC, k = i % DM;
        const int gc = j < 16 ? 1792 + j : 2832 + (j - 16);
        WGt[i] = f2bf(p.in[I_WIN][((size_t)l * DM + k) * INW + gc]);
    }
    for (int i = bid_ * 512 + tid; i < 2 * NE * DM; i += nblk_ * 512) {
        const int l = i / (NE * DM), e = (i / DM) % NE, k = i % DM;
        RWt[i] = f2bf(p.in[I_RW][((size_t)l * DM + k) * NE + e]);
    }
}

__device__ __forceinline__ void ph_mod(int wv, LAS unsigned char* lds) {
    const Params p = load_params();
    int wv_ = __builtin_amdgcn_readfirstlane(wv); asm volatile("" : "+s"(wv_)); int tid_; { int l_; asm volatile("v_mbcnt_lo_u32_b32 %0, -1, 0\n\tv_mbcnt_hi_u32_b32 %0, -1, %0" : "=v"(l_)); tid_ = wv_ * 64 + l_; } int bid_ = blockIdx.x; asm volatile("" : "+s"(bid_)); int nblk_ = gridDim.x; asm volatile("" : "+s"(nblk_));
    const int tid = tid_, lane = tid & 63, wave = tid >> 6;
    LAS float* sl = (LAS float*)lds;
    LAS float* red = sl + 3 * DM;
    for (int i = tid; i < 3 * DM; i += 512) {
        const int v = i / DM, k = i % DM;
        const float cv = v < 2 ? p.in[I_C][v * DM + k] : p.in[I_CCTX][k];
        sl[i] = siluf(cv);
    }
    __syncthreads();
    if (bid_ == nblk_ - 1) {
        float* RT = (float*)(p.ws + OFF_ROPE);
        for (int i = tid; i < 128 * 16; i += 512) { const float ang = (float)(i >> 4) * exp2f(-(float)(i & 15) * (13.287712379549449f / 16.f)); RT[i] = cosf(ang); RT[2048 + i] = sinf(ang); }
    }
    float* MODV = (float*)(p.ws + OFF_MODV);
    for (int item = bid_; item < 2 * 96; item += nblk_) {
        const int l = item / 96, col = (item % 96) * 64 + lane;
        const float* W = p.in[I_MODW] + (size_t)l * DM * NMOD + col;
        float a0 = 0.f, a1 = 0.f, a2 = 0.f;
        const int kb = wave * 128;
        for (int k0 = kb; k0 < kb + 128; k0 += 64) {
            float w[64];
#pragma unroll
            for (int i = 0; i < 64; ++i) w[i] = __builtin_nontemporal_load(W + (size_t)(k0 + i) * NMOD);
#pragma unroll
            for (int i = 0; i < 64; ++i) { a0 += sl[k0 + i] * w[i]; a1 += sl[DM + k0 + i] * w[i]; a2 += sl[2 * DM + k0 + i] * w[i]; }
        }
        red[(wave * 3 + 0) * 64 + lane] = a0; red[(wave * 3 + 1) * 64 + lane] = a1; red[(wave * 3 + 2) * 64 + lane] = a2;
        __syncthreads();
        if (wave < 3) {
            float s = 0.f;
#pragma unroll
            for (int w = 0; w < 8; ++w) s += red[(w * 3 + wave) * 64 + lane];
            MODV[((size_t)l * 3 + wave) * NMOD + col] = s + p.in[I_MODB][(size_t)l * NMOD + col];
        }
        __syncthreads();
    }
}

template <int NB>
__device__ __forceinline__ void skinny_proj(const GAS bf16_t* A16, const GAS bf16_t* Bt, int lane, f32x4 (&acc)[NB]) {
    const GAS bf16_t* ap = A16 + (size_t)(lane & 15) * DM + 8 * (lane >> 4);
    const GAS bf16_t* bp = Bt + (size_t)(lane & 15) * DM + 8 * (lane >> 4);
#pragma unroll
    for (int nb = 0; nb < NB; ++nb) acc[nb] = (f32x4){0.f, 0.f, 0.f, 0.f};
#pragma unroll 4
    for (int s = 0; s < DM / 32; ++s) {
        const bf16x8 a = *(const GAS bf16x8*)(ap + 32 * s);
#pragma unroll
        for (int nb = 0; nb < NB; ++nb) acc[nb] = __builtin_amdgcn_mfma_f32_16x16x32_bf16(a, *(const GAS bf16x8*)(bp + (size_t)nb * 16 * DM + 32 * s), acc[nb], 0, 0, 0);
    }
}
template <int NB>
__device__ __forceinline__ void stage_bt(const GAS bf16_t* Bt, LAS unsigned char* lds, int tid) {
    for (int i = tid; i < 16 * NB * 128; i += 512) { const int row = i >> 7, ch = i & 127; *(LAS u32x4*)(lds + row * 2064 + ch * 16) = *(const GAS u32x4*)(Bt + (size_t)row * DM + ch * 8); }
    __syncthreads();
}
template <int NB>
__device__ __forceinline__ void skinny_proj_l(const GAS bf16_t* A16, const LAS unsigned char* bl, int lane, f32x4 (&acc)[NB]) {
    const GAS bf16_t* ap = A16 + (size_t)(lane & 15) * DM + 8 * (lane >> 4);
    const LAS unsigned char* bp = bl + (lane & 15) * 2064 + 16 * (lane >> 4);
#pragma unroll
    for (int nb = 0; nb < NB; ++nb) acc[nb] = (f32x4){0.f, 0.f, 0.f, 0.f};
    bf16x8 a[32];
#pragma unroll
    for (int s = 0; s < 32; ++s) a[s] = *(const GAS bf16x8*)(ap + 32 * s);
#pragma unroll
    for (int s = 0; s < 32; ++s)
#pragma unroll
        for (int nb = 0; nb < NB; ++nb) acc[nb] = __builtin_amdgcn_mfma_f32_16x16x32_bf16(a[s], *(const LAS bf16x8*)(bp + nb * 16 * 2064 + 64 * s), acc[nb], 0, 0, 0);
}
__device__ __forceinline__ void ph_norm1(int wv, int layer, LAS unsigned char* lds) {
    const Params p = load_params();
    PHASE_IDS();
    const int tid = tid_, lane = tid & 63, wave = tid >> 6;
    const int gw = bid_ * 8 + wave, NGW = nblk_ * 8;
    const float* MODV = (const float*)(p.ws + OFF_MODV) + (size_t)layer * 3 * NMOD;
    const float* ng = p.in[I_N1G] + (size_t)layer * DM;
    GAS bf16_t* XA = (GAS bf16_t*)(p.ws + OFF_XA);
    const GAS bf16_t* WGt = (const GAS bf16_t*)(p.ws + OFF_WG) + (size_t)layer * NGC * DM;
    GAS float* G = (GAS float*)(p.ws + OFF_G);
    stage_bt<2>(WGt, lds, tid);
    for (int task = wave * nblk_ + bid_; task < NROW / 16; task += NGW) {
        const int row0 = task * 16;
        const float* mv = MODV + (size_t)row_sel(row0) * NMOD;
        f32x4 ga[4], sh[4];
#pragma unroll
        for (int j = 0; j < 4; ++j) {
            const int col = 4 * lane + 256 * j;
            const f32x4 g = *(const f32x4*)(ng + col), sc = *(const f32x4*)(mv + DM + col);
            sh[j] = *(const f32x4*)(mv + col);
            ga[j] = g * (sc + (f32x4){1.f, 1.f, 1.f, 1.f});
        }
#pragma unroll 1
        for (int rb = 0; rb < 16; rb += 4) {
            f32x4 v[4][4];
#pragma unroll
            for (int q = 0; q < 4; ++q) {
#pragma unroll
                for (int j = 0; j < 4; ++j) v[q][j] = xin4(p, layer, row0 + rb + q, 4 * lane + 256 * j);
            }
#pragma unroll
            for (int q = 0; q < 4; ++q) {
                float ss = 0.f;
#pragma unroll
                for (int j = 0; j < 4; ++j) ss += v[q][j].x * v[q][j].x + v[q][j].y * v[q][j].y + v[q][j].z * v[q][j].z + v[q][j].w * v[q][j].w;
                const float rstd = rsqrtf(wave_sum(ss) * (1.f / DM) + EPS);
#pragma unroll
                for (int j = 0; j < 4; ++j) {
                    const f32x4 h = v[q][j] * rstd * ga[j] + sh[j];
                    u32x2 o; o.x = pk_bf16(h.x, h.y); o.y = pk_bf16(h.z, h.w);
                    *(GAS u32x2*)(XA + (size_t)(row0 + rb + q) * DM + 4 * lane + 256 * j) = o;
                }
            }
        }
        __builtin_amdgcn_fence(__ATOMIC_RELEASE, "workgroup"); __builtin_amdgcn_fence(__ATOMIC_ACQUIRE, "workgroup");
        f32x4 acc[2];
        skinny_proj_l<2>(XA + (size_t)row0 * DM, lds, lane, acc);
#pragma unroll
        for (int nb = 0; nb < 2; ++nb)
#pragma unroll
            for (int i = 0; i < 4; ++i) G[(size_t)(row0 + 4 * (lane >> 4) + i) * NGC + 16 * nb + (lane & 15)] = acc[nb][i];
    }
}

namespace g8 {
constexpr int HTB = 128 * 64 * 2;
__device__ __forceinline__ int lds_byte(int r, int c) { const int st = (r >> 4) * 2 + (c >> 5), rr = r & 15, cc = c & 31, ob = rr * 64 + cc * 2; return st * 1024 + (ob ^ (((ob >> 9) & 1) << 5)); }
__device__ __forceinline__ void stage_rc(int b, int& R, int& C) { const int st = b / 1024, sb = b % 1024, swz = sb ^ (((sb >> 9) & 1) << 5); R = (st >> 1) * 16 + swz / 64; C = (st & 1) * 32 + (swz % 64) / 2; }

template <class Epi>
__device__ __forceinline__ void gemm_unit(const int tid, LAS unsigned char* lds, const char* Ab, const unsigned (&voA)[2][2], const char* Bb, const unsigned (&voB)[2][2], int nt, const Epi& epi) {
    const int wid = __builtin_amdgcn_readfirstlane(tid >> 6), lane = tid & 63, wr = wid >> 2, wc = wid & 3, fr = lane & 15, fq = lane >> 4;
    const unsigned ldsw = (unsigned)wid * 1024u;
    const int aoff = lds_byte(wr * 64 + fr, fq * 8), boff = lds_byte(wc * 32 + fr, fq * 8);
#define G8_SA(b, h) (((b) * 2 + (h)) * HTB)
#define G8_SB(b, h) ((4 + (b) * 2 + (h)) * HTB)
#define G8_STAGE(bufoff, gbase, voff, kt) do { _Pragma("unroll") for (int _i = 0; _i < 2; ++_i) \
        __builtin_amdgcn_global_load_lds((const unsigned*)((gbase) + (voff)[_i] + (size_t)(kt) * 128), (LAS unsigned*)(lds + (bufoff) + ldsw + _i * 8192), 16, 0, 0); } while (0)
#define G8_LDA(dst, b, h) do { _Pragma("unroll") for (int m = 0; m < 4; ++m) _Pragma("unroll") for (int k = 0; k < 2; ++k) dst[m][k] = *(const LAS bf16x8*)(lds + G8_SA(b, h) + aoff + m * 2048 + k * 1024); } while (0)
#define G8_LDB(dst, b, h) do { _Pragma("unroll") for (int n = 0; n < 2; ++n) _Pragma("unroll") for (int k = 0; k < 2; ++k) dst[n][k] = *(const LAS bf16x8*)(lds + G8_SB(b, h) + boff + n * 2048 + k * 1024); } while (0)
#define G8_MMA(ai, bj, At, Bt) do { __builtin_amdgcn_s_setprio(1); _Pragma("unroll") for (int m = 0; m < 4; ++m) _Pragma("unroll") for (int n = 0; n < 2; ++n) _Pragma("unroll") for (int k = 0; k < 2; ++k) \
        acc[ai][bj][m][n] = __builtin_amdgcn_mfma_f32_16x16x32_bf16(Bt[n][k], At[m][k], acc[ai][bj][m][n], 0, 0, 0); __builtin_amdgcn_s_setprio(0); } while (0)
#define G8_WV(n) asm volatile("s_waitcnt vmcnt(" #n ")" ::: "memory")
#define G8_WL(n) asm volatile("s_waitcnt lgkmcnt(" #n ")" ::: "memory")
#define G8_BAR __builtin_amdgcn_s_barrier()
#define G8_SCHED __builtin_amdgcn_sched_barrier(0)
    f32x4 acc[2][2][4][2];
#pragma unroll
    for (int a = 0; a < 2; ++a)
#pragma unroll
        for (int b = 0; b < 2; ++b)
#pragma unroll
            for (int m = 0; m < 4; ++m)
#pragma unroll
                for (int n = 0; n < 2; ++n) acc[a][b][m][n] = (f32x4){0.f, 0.f, 0.f, 0.f};
    bf16x8 At[4][2], B0[2][2], B1[2][2];
    G8_STAGE(G8_SB(0, 0), Bb, voB[0], 0); G8_STAGE(G8_SA(0, 0), Ab, voA[0], 0); G8_STAGE(G8_SB(0, 1), Bb, voB[1], 0); G8_STAGE(G8_SA(0, 1), Ab, voA[1], 0);
    if (wr == 1) G8_BAR;
    G8_WV(4); G8_BAR;
    G8_STAGE(G8_SB(1, 0), Bb, voB[0], 1); G8_STAGE(G8_SA(1, 0), Ab, voA[0], 1); G8_STAGE(G8_SB(1, 1), Bb, voB[1], 1);
    G8_WV(6); G8_BAR;
    for (int t = 0; t < nt - 2; t += 2) {
        G8_LDB(B0, 0, 0); G8_SCHED; G8_LDA(At, 0, 0); G8_STAGE(G8_SA(1, 1), Ab, voA[1], t + 1);
        G8_WL(8); G8_BAR; G8_WL(0); G8_MMA(0, 0, At, B0); G8_BAR; G8_SCHED;
        G8_LDB(B1, 0, 1); G8_STAGE(G8_SB(0, 0), Bb, voB[0], t + 2);
        G8_BAR; G8_WL(0); G8_MMA(0, 1, At, B1); G8_BAR;
        G8_LDA(At, 0, 1); G8_STAGE(G8_SA(0, 0), Ab, voA[0], t + 2);
        G8_BAR; G8_WL(0); G8_MMA(1, 0, At, B0); G8_BAR; G8_SCHED;
        G8_STAGE(G8_SB(0, 1), Bb, voB[1], t + 2);
        G8_WV(6); G8_BAR; G8_MMA(1, 1, At, B1); G8_BAR;
        G8_LDB(B0, 1, 0); G8_SCHED; G8_LDA(At, 1, 0); G8_STAGE(G8_SA(0, 1), Ab, voA[1], t + 2);
        G8_WL(8); G8_BAR; G8_WL(0); G8_MMA(0, 0, At, B0); G8_BAR; G8_SCHED;
        G8_LDB(B1, 1, 1); G8_STAGE(G8_SB(1, 0), Bb, voB[0], t + 3);
        G8_BAR; G8_WL(0); G8_MMA(0, 1, At, B1); G8_BAR;
        G8_LDA(At, 1, 1); G8_STAGE(G8_SA(1, 0), Ab, voA[0], t + 3);
        G8_BAR; G8_WL(0); G8_MMA(1, 0, At, B0); G8_BAR; G8_SCHED;
        G8_STAGE(G8_SB(1, 1), Bb, voB[1], t + 3);
        G8_WV(6); G8_BAR; G8_MMA(1, 1, At, B1); G8_BAR;
    }
    { G8_LDB(B0, 0, 0); G8_LDA(At, 0, 0); G8_STAGE(G8_SA(1, 1), Ab, voA[1], nt - 1);
      G8_BAR; G8_WL(0); G8_MMA(0, 0, At, B0); G8_BAR;
      G8_LDB(B1, 0, 1); G8_BAR; G8_WL(0); G8_MMA(0, 1, At, B1); G8_BAR;
      G8_LDA(At, 0, 1); G8_WV(4); G8_BAR; G8_WL(0); G8_MMA(1, 0, At, B0); G8_MMA(1, 1, At, B1); G8_BAR; }
    { G8_LDB(B0, 1, 0); G8_LDA(At, 1, 0); G8_WV(2); G8_BAR; G8_WL(0); G8_MMA(0, 0, At, B0); G8_BAR;
      G8_LDB(B1, 1, 1); G8_WV(0); G8_BAR; G8_WL(0); G8_MMA(0, 1, At, B1); G8_BAR;
      G8_LDA(At, 1, 1); G8_BAR; G8_WL(0); G8_MMA(1, 0, At, B0); G8_MMA(1, 1, At, B1); G8_BAR; }
    if (wr == 0) G8_BAR;
    epi(acc, wr, wc, fr, fq);
    G8_WV(0);
#undef G8_SA
#undef G8_SB
#undef G8_STAGE
#undef G8_LDA
#undef G8_LDB
#undef G8_MMA
#undef G8_WV
#undef G8_WL
#undef G8_BAR
#undef G8_SCHED
}
__device__ __forceinline__ void my_stage_rc(int tid, int (&R)[2], int (&C)[2]) {
#pragma unroll
    for (int i = 0; i < 2; ++i) stage_rc(tid * 16 + i * 8192, R[i], C[i]);
}
}

__device__ __forceinline__ void ph_gemm_in(int wv, int layer, LAS unsigned char* lds) {
    const Params p = load_params();
    int wv_ = __builtin_amdgcn_readfirstlane(wv); asm volatile("" : "+s"(wv_)); int tid_; { int l_; asm volatile("v_mbcnt_lo_u32_b32 %0, -1, 0\n\tv_mbcnt_hi_u32_b32 %0, -1, %0" : "=v"(l_)); tid_ = wv_ * 64 + l_; } int bid_ = blockIdx.x; asm volatile("" : "+s"(bid_)); int nblk_ = gridDim.x; asm volatile("" : "+s"(nblk_));
    int R[2], C[2]; g8::my_stage_rc(tid_, R, C);
    const char* Ab = (const char*)(p.ws + OFF_XA);
    const char* Bb = (const char*)((const bf16_t*)(p.ws + OFF_WTIN) + (size_t)layer * NPC * DM);
    bf16_t* P = (bf16_t*)(p.ws + OFF_PB);
    constexpr int NM = NROW / 256, NN = NPC / 256;
    const int vb = (nblk_ % 8 == 0) ? (bid_ % 8) * (nblk_ / 8) + bid_ / 8 : bid_;
    for (int u = vb; u < NM * NN; u += nblk_) {
        const int pm = u / NN, pn = u % NN;
        unsigned voA[2][2], voB[2][2];
#pragma unroll
        for (int h = 0; h < 2; ++h)
#pragma unroll
            for (int i = 0; i < 2; ++i) { voA[h][i] = (unsigned)(((pm * 256 + h * 128 + R[i]) * DM + C[i]) * 2); voB[h][i] = (unsigned)(((pn * 256 + h * 128 + R[i]) * DM + C[i]) * 2); }
        g8::gemm_unit(tid_, lds, Ab, voA, Bb, voB, DM / 64, [&](const f32x4 (&acc)[2][2][4][2], int wr, int wc, int fr, int fq) {
#pragma unroll
            for (int ai = 0; ai < 2; ++ai)
#pragma unroll
                for (int m = 0; m < 4; ++m) {
                    const int row = pm * 256 + ai * 128 + wr * 64 + m * 16 + fr;
#pragma unroll
                    for (int bj = 0; bj < 2; ++bj)
#pragma unroll
                        for (int n = 0; n < 2; ++n) { const int col = pn * 256 + bj * 128 + wc * 32 + n * 16 + fq * 4; const f32x4 a = acc[ai][bj][m][n]; u32x2 o; o.x = pk_bf16(a.x, a.y); o.y = pk_bf16(a.z, a.w); *(u32x2*)(P + (size_t)row * NPC + col) = o; }
                }
        });
    }
}

__device__ __forceinline__ void ph_gemm_out(int wv, int layer, LAS unsigned char* lds) {
    const Params p = load_params();
    int wv_ = __builtin_amdgcn_readfirstlane(wv); asm volatile("" : "+s"(wv_)); int tid_; { int l_; asm volatile("v_mbcnt_lo_u32_b32 %0, -1, 0\n\tv_mbcnt_hi_u32_b32 %0, -1, %0" : "=v"(l_)); tid_ = wv_ * 64 + l_; } int bid_ = blockIdx.x; asm volatile("" : "+s"(bid_)); int nblk_ = gridDim.x; asm volatile("" : "+s"(nblk_));
    int R[2], C[2]; g8::my_stage_rc(tid_, R, C);
    const char* Ab = (const char*)(p.ws + OFF_Y);
    const char* Bb = (const char*)((const bf16_t*)(p.ws + OFF_WTOUT) + (size_t)layer * DM * DM);
    bf16_t* X1 = (bf16_t*)(p.ws + OFF_X1);
    const float* MODV = (const float*)(p.ws + OFF_MODV) + (size_t)layer * 3 * NMOD;
    const int NM = (layer == 0 ? NROW : NLAT) / 256, NN = DM / 256;
    const int vb = (nblk_ % 8 == 0) ? (bid_ % 8) * (nblk_ / 8) + bid_ / 8 : bid_;
    for (int u = vb; u < NM * NN; u += nblk_) {
        const int pm = u / NN, pn = u % NN;
        unsigned voA[2][2], voB[2][2];
#pragma unroll
        for (int h = 0; h < 2; ++h)
#pragma unroll
            for (int i = 0; i < 2; ++i) { voA[h][i] = (unsigned)(((pm * 256 + h * 128 + R[i]) * DM + C[i]) * 2); voB[h][i] = (unsigned)(((pn * 256 + h * 128 + R[i]) * DM + C[i]) * 2); }
        const float* g1 = MODV + (size_t)row_sel(pm * 256) * NMOD + 2 * DM;
        g8::gemm_unit(tid_, lds, Ab, voA, Bb, voB, DM / 64, [&](const f32x4 (&acc)[2][2][4][2], int wr, int wc, int fr, int fq) {
#pragma unroll
            for (int ai = 0; ai < 2; ++ai)
#pragma unroll
                for (int m = 0; m < 4; ++m) {
                    const int row = pm * 256 + ai * 128 + wr * 64 + m * 16 + fr;
#pragma unroll
                    for (int bj = 0; bj < 2; ++bj)
#pragma unroll
                        for (int n = 0; n < 2; ++n) {
                            const int col = pn * 256 + bj * 128 + wc * 32 + n * 16 + fq * 4;
                            const f32x4 xv = xin4(p, layer, row, col), gv = *(const f32x4*)(g1 + col);
                            st4_bf16(X1 + (size_t)row * DM + col, xv + gv * acc[ai][bj][m][n]);
                        }
                }
        });
    }
}

__device__ __forceinline__ void ph_moe1(int wv, int layer, LAS unsigned char* lds) {
    const Params p = load_params();
    int wv_ = __builtin_amdgcn_readfirstlane(wv); asm volatile("" : "+s"(wv_)); int tid_; { int l_; asm volatile("v_mbcnt_lo_u32_b32 %0, -1, 0\n\tv_mbcnt_hi_u32_b32 %0, -1, %0" : "=v"(l_)); tid_ = wv_ * 64 + l_; } int bid_ = blockIdx.x; asm volatile("" : "+s"(bid_)); int nblk_ = gridDim.x; asm volatile("" : "+s"(nblk_));
    int R[2], C[2]; g8::my_stage_rc(tid_, R, C);
    const char* Ab = (const char*)(p.ws + OFF_XA);
    const int* IDX = (const int*)(p.ws + OFF_IDX);
    bf16_t* HID = (bf16_t*)(p.ws + OFF_HID);
    const int nunits = (layer == 0 ? NE * 9 : NE * 8) * 16;
    const int vb = (nblk_ % 8 == 0) ? (bid_ % 8) * (nblk_ / 8) + bid_ / 8 : bid_;
    for (int u = vb; u < nunits; u += nblk_) {
        int e, hr0, nvalid, nt;
        if (u < NE * 8 * 16) { e = u / 128; const int rem = u % 128, mt = rem % 8; nt = rem / 8; hr0 = e * 2048 + mt * 256; nvalid = 256; }
        else { const int v = u - NE * 8 * 16; e = v / 16; nt = v % 16; hr0 = NB * NE * CAPL + e * 64; nvalid = 64; }
        const char* Bb = (const char*)((const bf16_t*)(p.ws + OFF_WT13) + ((size_t)layer * NE + e) * 4096 * DM);
        unsigned voA[2][2], voB[2][2];
#pragma unroll
        for (int h = 0; h < 2; ++h)
#pragma unroll
            for (int i = 0; i < 2; ++i) {
                const int tr = (h * 128 + R[i]) & (nvalid - 1);
                const int rowid = IDX[hr0 + tr];
                voA[h][i] = (unsigned)((rowid * DM + C[i]) * 2);
                voB[h][i] = (unsigned)(((nt * 256 + h * 128 + R[i]) * DM + C[i]) * 2);
            }
        g8::gemm_unit(tid_, lds, Ab, voA, Bb, voB, DM / 64, [&](const f32x4 (&acc)[2][2][4][2], int wr, int wc, int fr, int fq) {
#pragma unroll
            for (int ai = 0; ai < 2; ++ai)
#pragma unroll
                for (int m = 0; m < 4; ++m) {
                    const int tr = ai * 128 + wr * 64 + m * 16 + fr;
                    if (tr < nvalid) {
#pragma unroll
                        for (int n = 0; n < 2; ++n) {
                            const int f = nt * 128 + wc * 32 + n * 16 + fq * 4;
                            const f32x4 a = acc[ai][0][m][n], b = acc[ai][1][m][n];
                            u32x2 o; o.x = pk_bf16(fsilu(a.x) * b.x, fsilu(a.y) * b.y); o.y = pk_bf16(fsilu(a.z) * b.z, fsilu(a.w) * b.w);
                            *(u32x2*)(HID + (size_t)(hr0 + tr) * FF + f) = o;
                        }
                    }
                }
        });
    }
}
__device__ __forceinline__ void ph_moe2(int wv, int layer, LAS unsigned char* lds) {
    const Params p = load_params();
    int wv_ = __builtin_amdgcn_readfirstlane(wv); asm volatile("" : "+s"(wv_)); int tid_; { int l_; asm volatile("v_mbcnt_lo_u32_b32 %0, -1, 0\n\tv_mbcnt_hi_u32_b32 %0, -1, %0" : "=v"(l_)); tid_ = wv_ * 64 + l_; } int bid_ = blockIdx.x; asm volatile("" : "+s"(bid_)); int nblk_ = gridDim.x; asm volatile("" : "+s"(nblk_));
    int R[2], C[2]; g8::my_stage_rc(tid_, R, C);
    const char* Ab = (const char*)(p.ws + OFF_HID);
    const float* VALS = (const float*)(p.ws + OFF_VALS);
    bf16_t* YE = (bf16_t*)(p.ws + OFF_YE);
    const int nunits = NE * 8 * 4 + (layer == 0 ? NE * 4 * 4 : 0);
    const int vb = (nblk_ % 8 == 0) ? (bid_ % 8) * (nblk_ / 8) + bid_ / 8 : bid_;
    for (int u = vb; u < nunits; u += nblk_) {
        int e, hr0, nvalid, nt, kq = 0, nkt = FF / 64;
        bf16_t* yout;
        if (u < NE * 8 * 4) { e = u / 32; const int rem = u % 32, mt = rem % 8; nt = rem / 8; hr0 = e * 2048 + mt * 256; nvalid = 256; yout = YE + (size_t)hr0 * DM; }
        else { const int v = u - NE * 8 * 4; e = v >> 4; nt = (v >> 2) & 3; kq = v & 3; hr0 = NB * NE * CAPL + e * 64; nvalid = 64; nkt = FF / 64 / 4; yout = (bf16_t*)(p.ws + OFF_YEC) + (size_t)(kq * 1024 + e * 64) * DM; }
        const char* Bb = (const char*)((const bf16_t*)(p.ws + OFF_WT2) + ((size_t)layer * NE + e) * DM * FF);
        unsigned voA[2][2], voB[2][2];
#pragma unroll
        for (int h = 0; h < 2; ++h)
#pragma unroll
            for (int i = 0; i < 2; ++i) {
                const int tr = (h * 128 + R[i]) & (nvalid - 1);
                voA[h][i] = (unsigned)(((size_t)(hr0 + tr) * FF + C[i] + kq * 512) * 2);
                voB[h][i] = (unsigned)(((nt * 256 + h * 128 + R[i]) * FF + C[i] + kq * 512) * 2);
            }
        g8::gemm_unit(tid_, lds, Ab, voA, Bb, voB, nkt, [&](const f32x4 (&acc)[2][2][4][2], int wr, int wc, int fr, int fq) {
#pragma unroll
            for (int ai = 0; ai < 2; ++ai)
#pragma unroll
                for (int m = 0; m < 4; ++m) {
                    const int tr = ai * 128 + wr * 64 + m * 16 + fr;
                    if (tr < nvalid) {
                        const float vv = VALS[hr0 + tr];
#pragma unroll
                        for (int bj = 0; bj < 2; ++bj)
#pragma unroll
                            for (int n = 0; n < 2; ++n) { const int col = nt * 256 + bj * 128 + wc * 32 + n * 16 + fq * 4; const f32x4 yv = acc[ai][bj][m][n] * vv; u32x2 o; o.x = pk_bf16(yv.x, yv.y); o.y = pk_bf16(yv.z, yv.w); *(u32x2*)(yout + (size_t)tr * DM + col) = o; }
                    }
                }
        });
    }
}

__device__ __forceinline__ void unpack8(const u32x4 w, float (&f)[8]) {
    f[0] = __uint_as_float(w.x << 16); f[1] = __uint_as_float(w.x & 0xffff0000u); f[2] = __uint_as_float(w.y << 16); f[3] = __uint_as_float(w.y & 0xffff0000u);
    f[4] = __uint_as_float(w.z << 16); f[5] = __uint_as_float(w.z & 0xffff0000u); f[6] = __uint_as_float(w.w << 16); f[7] = __uint_as_float(w.w & 0xffff0000u);
}
__device__ __forceinline__ u32x4 pack8(const float (&f)[8]) { u32x4 o; o.x = pk_bf16(f[0], f[1]); o.y = pk_bf16(f[2], f[3]); o.z = pk_bf16(f[4], f[5]); o.w = pk_bf16(f[6], f[7]); return o; }
__device__ __forceinline__ float sum8lanes(float v) { v += xor_lane<1>(v); v += xor_lane<2>(v); v += xor_lane<4>(v); return v; }
__device__ __forceinline__ void ph_prep(int wv, int layer) {
    const Params p = load_params();
    PHASE_IDS();
    const int tid = tid_, lane = tid & 63, wave = tid >> 6;
    const int gw = bid_ * 8 + wave, NGW = nblk_ * 8;
    const GAS bf16_t* P = (const GAS bf16_t*)(p.ws + OFF_PB);
    GAS bf16_t* QB = (GAS bf16_t*)(p.ws + OFF_QB); GAS bf16_t* KB = (GAS bf16_t*)(p.ws + OFF_KB); GAS bf16_t* VN = (GAS bf16_t*)(p.ws + OFF_VT);
    GAS bf16_t* GQ = (GAS bf16_t*)(p.ws + OFF_GQB); GAS bf16_t* GK = (GAS bf16_t*)(p.ws + OFF_GKB); GAS bf16_t* GV = (GAS bf16_t*)(p.ws + OFF_GVB);
    const float* RT = (const float*)(p.ws + OFF_ROPE);
    const int i8 = lane & 7, d0 = 8 * i8;
    const int axis = i8 >> 2, half = (i8 >> 1) & 1, f0 = 8 * (i8 & 1);
    float qg[8], kg[8];
#pragma unroll
    for (int j = 0; j < 8; ++j) { qg[j] = p.in[I_QNG][layer * 64 + d0 + j]; kg[j] = p.in[I_KNG][layer * 64 + d0 + j]; }
    const float* cw = p.in[I_GCW] + (size_t)layer * 5 * 768;
    f32x4 cwa[2][5][2];
#pragma unroll
    for (int pass = 0; pass < 2; ++pass)
#pragma unroll
        for (int t = 0; t < 5; ++t) {
            const int ch0 = (pass == 1 && lane >= 32) ? 0 : pass * 512 + 8 * lane;
            cwa[pass][t][0] = *(const f32x4*)(cw + t * 768 + ch0); cwa[pass][t][1] = *(const f32x4*)(cw + t * 768 + ch0 + 4);
        }
    for (int r = gw; r < NROW; r += NGW) {
        const bool lat = r < NLAT;
        const int b = lat ? (r >> 13) : ((r - NLAT) >> 8);
        const int n = lat ? (r & (SEQ - 1)) : ((r - NLAT) & (CTXL - 1));
        const GAS bf16_t* pr = P + (size_t)r * NPC;
        float cs[8], sn[8];
        if (lat) {
            const int pos = axis == 0 ? (n >> 6) : (n & 63);
            const f32x4 c0 = *(const f32x4*)(RT + pos * 16 + f0), c1 = *(const f32x4*)(RT + pos * 16 + f0 + 4), s0 = *(const f32x4*)(RT + 2048 + pos * 16 + f0), s1 = *(const f32x4*)(RT + 2048 + pos * 16 + f0 + 4);
#pragma unroll
            for (int j = 0; j < 4; ++j) { cs[j] = c0[j]; cs[4 + j] = c1[j]; sn[j] = s0[j]; sn[4 + j] = s1[j]; }
        } else {
#pragma unroll
            for (int j = 0; j < 8; ++j) { cs[j] = 1.f; sn[j] = 0.f; }
        }
        const int kpos = lat ? CTXL + n : n;
        const int slen = lat ? SEQ : CTXL;
        const u32x4 qraw = *(const GAS u32x4*)(pr + 8 * lane);
        u32x4 kvraw = {0u, 0u, 0u, 0u};
        if (lane < 32) kvraw = *(const GAS u32x4*)(pr + 512 + 8 * lane);
        u32x4 tp0[5], tp1[5]; float tm[5];
#pragma unroll
        for (int t = 0; t < 5; ++t) {
            const int nn = n + t - 2;
            const bool ok = nn >= 0 && nn < slen;
            const GAS bf16_t* tr = P + (size_t)(ok ? r + t - 2 : r) * NPC + 1792 + 8 * lane;
            tm[t] = ok ? 1.f : 0.f;
            tp0[t] = *(const GAS u32x4*)tr;
            tp1[t] = (u32x4){0u, 0u, 0u, 0u};
            if (lane < 32) tp1[t] = *(const GAS u32x4*)(tr + 512);
        }
        {
            float v[8]; unpack8(qraw, v);
            float ss = 0.f;
#pragma unroll
            for (int j = 0; j < 8; ++j) ss += v[j] * v[j];
            const float rstd = rsqrtf(sum8lanes(ss) * (1.f / 64.f) + EPS);
            float o[8];
#pragma unroll
            for (int j = 0; j < 8; ++j) { const float y = v[j] * rstd * qg[j]; const float pv = xor_lane<2>(y); o[j] = (half == 0 ? y * cs[j] - pv * sn[j] : y * cs[j] + pv * sn[j]) * QSCALE; }
            *(GAS u32x4*)(QB + (size_t)r * 512 + 8 * lane) = pack8(o);
        }
        if (lane < 32) {
            const u32x4 raw = kvraw;
            float v[8]; unpack8(raw, v);
            float ss = 0.f;
#pragma unroll
            for (int j = 0; j < 8; ++j) ss += v[j] * v[j];
            const float rstd = rsqrtf(sum8lanes(ss) * (1.f / 64.f) + EPS);
            float o[8];
#pragma unroll
            for (int j = 0; j < 8; ++j) { const float y = v[j] * rstd * kg[j]; const float pv = xor_lane<2>(y); o[j] = half == 0 ? y * cs[j] - pv * sn[j] : y * cs[j] + pv * sn[j]; }
            const int g = (lane >> 3) & 1;
            if (lane < 16) *(GAS u32x4*)(KB + ((size_t)(b * 2 + g) * KPOS + kpos) * 64 + d0) = pack8(o);
            else *(GAS u32x4*)(VN + ((size_t)(b * 2 + g) * KPOS + kpos) * 64 + d0) = raw;
        }
#pragma unroll
        for (int pass = 0; pass < 2; ++pass) {
            if (pass == 1 && lane >= 32) break;
            const int ch0 = pass * 512 + 8 * lane;
            float a[8];
#pragma unroll
            for (int j = 0; j < 8; ++j) a[j] = 0.f;
#pragma unroll
            for (int t = 0; t < 5; ++t) {
                {
                    float v[8]; unpack8(pass == 0 ? tp0[t] : tp1[t], v);
                    const f32x4 w0 = cwa[pass][t][0] * tm[t], w1 = cwa[pass][t][1] * tm[t];
#pragma unroll
                    for (int j = 0; j < 4; ++j) { a[j] += v[j] * w0[j]; a[4 + j] += v[4 + j] * w1[j]; }
                }
            }
            float ss = 0.f;
#pragma unroll
            for (int j = 0; j < 8; ++j) { a[j] = fsilu(a[j]); ss += a[j] * a[j]; }
            if (pass == 0) {
                const float sc = rsqrtf(sum8lanes(ss) + EPS) * (lane < 32 ? 0.125f : 1.f);
#pragma unroll
                for (int j = 0; j < 8; ++j) a[j] *= sc;
                if (lane < 32) *(GAS u32x4*)(GQ + (size_t)r * 256 + 8 * lane) = pack8(a);
                else *(GAS u32x4*)(GK + (size_t)r * 256 + 8 * (lane - 32)) = pack8(a);
            } else *(GAS u32x4*)(GV + (size_t)r * 256 + 8 * lane) = pack8(a);
        }
    }
}

template <int U> __device__ __forceinline__ bf16x8 acc_frag(const f32x16& a);
__device__ __forceinline__ bf16x8 mk_frag(u32x2 lo, u32x2 hi8);
__device__ __forceinline__ void vt_store(LAS unsigned char* vt, int key, int dch, u32x4 v) {
    LAS unsigned short* b = (LAS unsigned short*)(vt + (8 * dch) * 136 + key * 2);
    b[0 * 68] = (unsigned short)v.x; b[1 * 68] = (unsigned short)(v.x >> 16); b[2 * 68] = (unsigned short)v.y; b[3 * 68] = (unsigned short)(v.y >> 16);
    b[4 * 68] = (unsigned short)v.z; b[5 * 68] = (unsigned short)(v.z >> 16); b[6 * 68] = (unsigned short)v.w; b[7 * 68] = (unsigned short)(v.w >> 16);
}
namespace attn_body {
using bf16=__hip_bfloat16;
using bf16x8=__attribute__((ext_vector_type(8)))short;
using s16x4=__attribute__((ext_vector_type(4)))short;
using f32x16=__attribute__((ext_vector_type(16)))float;
using u32x4=__attribute__((ext_vector_type(4)))unsigned;
constexpr int D=64, QP=512, KVP=64, OP=1024;
constexpr int NW=8,QBLK=32,QB=QBLK*NW,KVBLK=64;
__device__ __forceinline__ int crow(int r,int hi){return (r&3)+8*(r>>2)+4*hi;}
#define SBAR() __builtin_amdgcn_sched_barrier(0)
constexpr int NSLOT=3, SLOTB=8192;
constexpr int LDS_K=0, LDS_V=NSLOT*SLOTB, LDS_WS=2*NSLOT*SLOTB, LDS_OST=LDS_WS+NW*64*4, LDS_BYTES=LDS_OST+NW*4096;
constexpr float C2=0.125f*1.4426950408889634f;
__device__ __forceinline__ void glds16(const void*gsrc,unsigned lds_dst){unsigned keep;
  asm volatile("s_mov_b32 %0, m0\n\ts_mov_b32 m0, %2\n\ts_nop 0\n\tglobal_load_lds_dwordx4 %1, off\n\ts_mov_b32 m0, %0":"=&s"(keep):"v"(gsrc),"s"(lds_dst):"memory");}
__device__ __forceinline__ float max3f(float a,float b,float c){float r;asm("v_max3_f32 %0, %1, %2, %3":"=v"(r):"v"(a),"v"(b),"v"(c));return r;}
__device__ __forceinline__ float max2f(float a,float b){float r;asm("v_max_f32_e32 %0, %1, %2":"=v"(r):"v"(a),"v"(b));return r;}
__device__ __forceinline__ float fadd_s(float a,float b){float r;asm("v_add_f32_e32 %0, %1, %2":"=v"(r):"v"(a),"v"(b));return r;}
__device__ __forceinline__ float fsub_s(float a,float b){float r;asm("v_sub_f32_e32 %0, %1, %2":"=v"(r):"v"(a),"v"(b));return r;}
typedef float f32x2_t __attribute__((ext_vector_type(2))); typedef __bf16 bf16x2_t __attribute__((ext_vector_type(2)));
__device__ __forceinline__ unsigned cvtpk_s(float lo,float hi){f32x2_t v={lo,hi};bf16x2_t b=__builtin_convertvector(v,bf16x2_t);return __builtin_bit_cast(unsigned,b);}
#define WAIT_BAR(N) asm volatile("s_waitcnt vmcnt(" #N ") lgkmcnt(0)\n\ts_barrier":::"memory")

__device__ __forceinline__ void qkt(f32x16&p0,f32x16&p1,const char*Kslot,const bf16x8*qr,const f32x16&negm,int r32,int hi){
  const char*kb=Kslot+hi*1024+r32*16;
  #pragma unroll
  for(int d0=0;d0<4;++d0){
    const bf16x8 b0=*reinterpret_cast<const bf16x8*>(kb+d0*2048);
    const bf16x8 b1=*reinterpret_cast<const bf16x8*>(kb+d0*2048+512);
    if(d0==0){p0=__builtin_amdgcn_mfma_f32_32x32x16_bf16(b0,qr[0],negm,0,0,0);p1=__builtin_amdgcn_mfma_f32_32x32x16_bf16(b1,qr[0],negm,0,0,0);}
    else{p0=__builtin_amdgcn_mfma_f32_32x32x16_bf16(b0,qr[d0],p0,0,0,0);p1=__builtin_amdgcn_mfma_f32_32x32x16_bf16(b1,qr[d0],p1,0,0,0);}}
}
typedef __attribute__((address_space(3))) const char* lds_cptr;
typedef short v4i16_t __attribute__((ext_vector_type(4)));
__device__ __forceinline__ void kload8(bf16x8*kf,lds_cptr kp){
  kf[0]=*(const __attribute__((address_space(3))) bf16x8*)(kp);      kf[1]=*(const __attribute__((address_space(3))) bf16x8*)(kp+512);
  kf[2]=*(const __attribute__((address_space(3))) bf16x8*)(kp+2048); kf[3]=*(const __attribute__((address_space(3))) bf16x8*)(kp+2560);
  kf[4]=*(const __attribute__((address_space(3))) bf16x8*)(kp+4096); kf[5]=*(const __attribute__((address_space(3))) bf16x8*)(kp+4608);
  kf[6]=*(const __attribute__((address_space(3))) bf16x8*)(kp+6144); kf[7]=*(const __attribute__((address_space(3))) bf16x8*)(kp+6656);
}
__device__ __forceinline__ void kload2(bf16x8*kf,lds_cptr kp,int j){ kf[2*j]=*(const __attribute__((address_space(3))) bf16x8*)(kp+j*2048); kf[2*j+1]=*(const __attribute__((address_space(3))) bf16x8*)(kp+j*2048+512); }
__device__ __forceinline__ s16x4 vtr(lds_cptr p){ return __builtin_bit_cast(s16x4,__builtin_amdgcn_ds_read_tr16_b64_v4i16((__attribute__((address_space(3))) v4i16_t*)p)); }
__device__ __forceinline__ float rowmax(const f32x16&p0,const f32x16&p1){
  float a=max3f(p0[0],p0[1],p1[0]),b=max3f(p0[2],p0[3],p1[1]);a=max3f(a,p1[2],p1[3]);
  #pragma unroll
  for(int r=4;r<16;r+=4){a=max3f(a,p0[r],p0[r+1]);b=max3f(b,p0[r+2],p0[r+3]);a=max3f(a,p1[r],p1[r+1]);b=max3f(b,p1[r+2],p1[r+3]);}
  const float m=max2f(a,b);
  auto rr=__builtin_amdgcn_permlane32_swap(__float_as_uint(m),__float_as_uint(m),false,false);
  return max2f(__uint_as_float(rr[0]),__uint_as_float(rr[1]));
}
__device__ __forceinline__ void pv(f32x16*o,int vb,bf16x8 pa0,bf16x8 pa1,bf16x8 pa2,bf16x8 pa3){
  #pragma unroll
  for(int d0=0;d0<2;++d0){s16x4 lo[4],hi[4];
    #pragma unroll
    for(int ks=0;ks<4;++ks){
      asm volatile("ds_read_b64_tr_b16 %0,%1 offset:%c2":"=&v"(lo[ks]):"v"(vb),"i"(d0*4096+ks*1024):"memory");
      asm volatile("ds_read_b64_tr_b16 %0,%1 offset:%c2":"=&v"(hi[ks]):"v"(vb),"i"(d0*4096+ks*1024+512):"memory");}
    asm volatile("s_waitcnt lgkmcnt(0)":::"memory");SBAR();
    #define PK(k) (bf16x8){lo[k][0],lo[k][1],lo[k][2],lo[k][3],hi[k][0],hi[k][1],hi[k][2],hi[k][3]}
    o[d0]=__builtin_amdgcn_mfma_f32_32x32x16_bf16(pa0,PK(0),o[d0],0,0,0);
    o[d0]=__builtin_amdgcn_mfma_f32_32x32x16_bf16(pa1,PK(1),o[d0],0,0,0);
    o[d0]=__builtin_amdgcn_mfma_f32_32x32x16_bf16(pa2,PK(2),o[d0],0,0,0);
    o[d0]=__builtin_amdgcn_mfma_f32_32x32x16_bf16(pa3,PK(3),o[d0],0,0,0);
    #undef PK
  }
}

#ifndef ATTN_STORE16
#define ATTN_STORE16(p,v) (*(u32x4*)(p)=(v))
#endif
template<int THRL> __device__ __forceinline__ void attn_unit(const int tid,const int NT,const bf16*Qw0,const bf16*__restrict__ Kh,const bf16*__restrict__ Vh,bf16*Ow0,char*shm,float*ML=nullptr){
  const int lane=tid&63,r32=lane&31,hi=lane>>5; const int wid=__builtin_amdgcn_readfirstlane(tid>>6);
  const bf16*Qw=Qw0+(long)(wid*QBLK)*QP;
  const unsigned lds0=(unsigned)(uintptr_t)shm;
  float*wsf=(float*)(shm+LDS_WS)+wid*64;
  const bf16*ksrc=Kh+(long)lane*KVP+wid*8;
  const bf16*vsrc=Vh+(long)(16*(wid&3)+(lane>>2))*KVP+(wid>>2)*32+(lane&3)*8;
  const unsigned kdst=lds0+LDS_K+wid*1024, vdst=lds0+LDS_V+wid*1024;
  #define DMA_K(t,slot) glds16(ksrc+(long)(t)*KVBLK*KVP,(unsigned)__builtin_amdgcn_readfirstlane(kdst+(slot)))
  #define DMA_V(t,slot) glds16(vsrc+(long)(t)*KVBLK*KVP,(unsigned)__builtin_amdgcn_readfirstlane(vdst+(slot)))
  const int vb0=(int)(lds0+LDS_V)+((lane>>4)&1)*32+(lane&3)*8+(4*hi+((lane&15)>>2))*64;
  const char*Kbase=shm+LDS_K; bf16x8 kf[8];
  const lds_cptr shm3=(lds_cptr)shm; const lds_cptr kp0=shm3+LDS_K+hi*1024+r32*16; const lds_cptr vp0=shm3+LDS_V+((lane>>4)&1)*32+(lane&3)*8+(4*hi+((lane&15)>>2))*64;
  DMA_K(0,0);DMA_V(0,0);DMA_K(1,SLOTB);
  bf16x8 qr[4];
  #pragma unroll
  for(int d0=0;d0<4;++d0)qr[d0]=*reinterpret_cast<const bf16x8*>(&Qw[(long)r32*QP+d0*16+hi*8]);
  float mhat=0.f,l_reg=0.f;f32x16 o[2];o[0]=f32x16{};o[1]=f32x16{};f32x16 negm=f32x16{};asm volatile("":"+v"(negm));
  #define CMASK(P0,P1,t) do{}while(0)
  bool resc=false;
  #define START(P0,P1) do{ const float rm=rowmax(P0,P1); resc=false; \
    { const float dl=rm; mhat=fadd_s(mhat,dl); \
      _Pragma("unroll") for(int r=0;r<16;++r){P0[r]=fsub_s(P0[r],dl);P1[r]=fsub_s(P1[r],dl);} \
      _Pragma("unroll") for(int r=0;r<16;++r)negm[r]=-mhat; asm volatile("":"+v"(negm)); } \
    _Pragma("unroll") for(int r=0;r<16;++r)P0[r]=__builtin_amdgcn_exp2f(P0[r]); }while(0)
  #define RESC() do{ if(resc){ asm volatile("s_waitcnt lgkmcnt(0)":::"memory"); \
      _Pragma("unroll") for(int d_=0;d_<2;++d_) _Pragma("unroll") for(int r=0;r<16;++r)o[d_][r]*=wsf[crow(r,hi)]; } }while(0)
  f32x16 pA0,pA1,pB0,pB1;
  int sl_prev=0,sl_cur=0,sl_next=SLOTB;
  #define ROT() do{sl_prev=sl_cur;sl_cur=sl_next;sl_next=(sl_next==(NSLOT-1)*SLOTB)?0:sl_next+SLOTB;}while(0)
  DMA_K(2,2*SLOTB);
  WAIT_BAR(3);
  qkt(pA0,pA1,Kbase,qr,negm,r32,hi);asm volatile("s_nop 15\n\ts_nop 7":"+v"(pA0),"+v"(pA1));CMASK(pA0,pA1,0);
  START(pA0,pA1);
  _Pragma("unroll") for(int r=0;r<16;++r)pA1[r]=__builtin_amdgcn_exp2f(pA1[r]);
  WAIT_BAR(0);
  DMA_K(3,0);DMA_V(1,SLOTB);
  ROT();
  kload8(kf,kp0+sl_cur);
  WAIT_BAR(2);
  s16x4 vlo[8],vhi[8]; u32x4 pw0,pw1,pw2,pw3;
  #define PKW(P,B) cvtpk_s(P[B],P[B+1])
  #define PAF(k) __builtin_bit_cast(bf16x8,pw##k)
  #define VFR(i) (bf16x8){vlo[i][0],vlo[i][1],vlo[i][2],vlo[i][3],vhi[i][0],vhi[i][1],vhi[i][2],vhi[i][3]}
  #define PIN(x) asm volatile("":"+v"(x))
  #define MX3(a,b,c) __builtin_fmaxf(__builtin_fmaxf((a),(b)),(c))
  #define GAPA(MF,A0,A1,A2,A3,W0,W1,PW) do{ MF; sacc+=A0; sacc+=A1; sacc+=A2; sacc+=A3; PIN(sacc); W0; W1; PIN(PW); SBAR(); }while(0)
  #define EX(v) __builtin_amdgcn_exp2f(v)
  #define GAPB(MF,X,B) do{ MF; X[B]=EX(X[B]); X[B+1]=EX(X[B+1]); X[B+2]=EX(X[B+2]); X[B+3]=EX(X[B+3]); PIN(X); SBAR(); }while(0)
  #define VRD(i) do{ vlo[i]=vtr(vp_+(((i)>>2)*4096+((i)&3)*1024)); vhi[i]=vtr(vp_+(((i)>>2)*4096+((i)&3)*1024+512)); }while(0)
  #define KRD(G,j) do{ if(G){ kload2(kf,kp0+sl_next,j); SBAR(); } }while(0)
  #define STEP(C0,C1,P0,P1,t,GK,GV,GL) do{ SBAR(); \
    const lds_cptr vp_=vp0+sl_prev; \
    VRD(0); SBAR(); float sacc=(P0[0]+P0[1]); \
    GAPA(C0=__builtin_amdgcn_mfma_f32_32x32x16_bf16(kf[0],qr[0],negm,0,0,0), P0[2],P0[3],P0[4],P0[5],     pw0[0]=PKW(P0,0), pw0[1]=PKW(P0,2), pw0); \
    VRD(4); SBAR(); GAPA(C1=__builtin_amdgcn_mfma_f32_32x32x16_bf16(kf[1],qr[0],negm,0,0,0), P0[6],P0[7],P0[8],P0[9],     pw0[2]=PKW(P0,4), pw0[3]=PKW(P0,6), pw0); \
    VRD(1); SBAR(); GAPA(C0=__builtin_amdgcn_mfma_f32_32x32x16_bf16(kf[2],qr[1],C0,0,0,0),   P0[10],P0[11],P0[12],P0[13], pw1[0]=PKW(P0,8), pw1[1]=PKW(P0,10), pw1); \
    VRD(5); SBAR(); GAPA(C1=__builtin_amdgcn_mfma_f32_32x32x16_bf16(kf[3],qr[1],C1,0,0,0),   P0[14],P0[15],P1[0],P1[1],   pw1[2]=PKW(P0,12),pw1[3]=PKW(P0,14), pw1); \
    VRD(2); SBAR(); GAPA(C0=__builtin_amdgcn_mfma_f32_32x32x16_bf16(kf[4],qr[2],C0,0,0,0),   P1[2],P1[3],P1[4],P1[5],     pw2[0]=PKW(P1,0), pw2[1]=PKW(P1,2), pw2); \
    VRD(6); SBAR(); GAPA(C1=__builtin_amdgcn_mfma_f32_32x32x16_bf16(kf[5],qr[2],C1,0,0,0),   P1[6],P1[7],P1[8],P1[9],     pw2[2]=PKW(P1,4), pw2[3]=PKW(P1,6), pw2); \
    VRD(3); SBAR(); GAPA(C0=__builtin_amdgcn_mfma_f32_32x32x16_bf16(kf[6],qr[3],C0,0,0,0),   P1[10],P1[11],P1[12],P1[13], pw3[0]=PKW(P1,8), pw3[1]=PKW(P1,10), pw3); \
    VRD(7); SBAR(); GAPA(C1=__builtin_amdgcn_mfma_f32_32x32x16_bf16(kf[7],qr[3],C1,0,0,0),   P1[14],P1[15],0.f,0.f,       pw3[2]=PKW(P1,12),pw3[3]=PKW(P1,14), pw3); \
    l_reg+=sacc; \
    if(GK){DMA_K((t)+3,sl_cur);} if(GV){DMA_V((t)+1,sl_next);} \
    CMASK(C0,C1,t); \
    { float a=MX3(C0[0],C0[1],C1[0]),b=MX3(C0[2],C0[3],C1[1]); a=MX3(a,C1[2],C1[3]); \
      _Pragma("unroll") for(int r=4;r<16;r+=4){a=MX3(a,C0[r],C0[r+1]);b=MX3(b,C0[r+2],C0[r+3]);a=MX3(a,C1[r],C1[r+1]);b=MX3(b,C1[r+2],C1[r+3]);} \
      float rm=__builtin_fmaxf(a,b); { auto rr=__builtin_amdgcn_permlane32_swap(__float_as_uint(rm),__float_as_uint(rm),false,false); rm=__builtin_fmaxf(__uint_as_float(rr[0]),__uint_as_float(rr[1])); } \
      resc=false; \
      if(__builtin_expect(__any(rm>(float)THRL),0)){ const float dl=__builtin_fmaxf(rm,0.f); mhat+=dl; \
        _Pragma("unroll") for(int r=0;r<16;++r){C0[r]-=dl;C1[r]-=dl;} \
        _Pragma("unroll") for(int r=0;r<16;++r)negm[r]=-mhat; asm volatile("":"+v"(negm)); \
        const float f=__builtin_amdgcn_exp2f(-dl); l_reg*=f; if(hi==0)wsf[r32]=f; resc=true; } } \
    SBAR(); \
    GAPB(o[0]=__builtin_amdgcn_mfma_f32_32x32x16_bf16(PAF(0),VFR(0),o[0],0,0,0), C0,0); \
    GAPB(o[1]=__builtin_amdgcn_mfma_f32_32x32x16_bf16(PAF(0),VFR(4),o[1],0,0,0), C0,4); \
    KRD(GL,0); GAPB(o[0]=__builtin_amdgcn_mfma_f32_32x32x16_bf16(PAF(1),VFR(1),o[0],0,0,0), C0,8); \
    KRD(GL,1); GAPB(o[1]=__builtin_amdgcn_mfma_f32_32x32x16_bf16(PAF(1),VFR(5),o[1],0,0,0), C0,12); \
    KRD(GL,2); GAPB(o[0]=__builtin_amdgcn_mfma_f32_32x32x16_bf16(PAF(2),VFR(2),o[0],0,0,0), C1,0); \
    KRD(GL,3); GAPB(o[1]=__builtin_amdgcn_mfma_f32_32x32x16_bf16(PAF(2),VFR(6),o[1],0,0,0), C1,4); \
    GAPB(o[0]=__builtin_amdgcn_mfma_f32_32x32x16_bf16(PAF(3),VFR(3),o[0],0,0,0), C1,8); \
    GAPB(o[1]=__builtin_amdgcn_mfma_f32_32x32x16_bf16(PAF(3),VFR(7),o[1],0,0,0), C1,12); \
    }while(0)
  int t=1;
  #undef CMASK
  #define CMASK(P0,P1,t) do{}while(0)
  for(;t+5<NT;t+=2){
    STEP(pB0,pB1,pA0,pA1,t,true,true,true);     WAIT_BAR(2); RESC(); ROT();
    STEP(pA0,pA1,pB0,pB1,t+1,true,true,true);   WAIT_BAR(2); RESC(); ROT();
  }
  #undef CMASK
  #define CMASK(P0,P1,t) do{}while(0)
  #define ENDW(tt) do{ if((tt)+3<NT){WAIT_BAR(2);} else if((tt)+2<NT){WAIT_BAR(1);} else {WAIT_BAR(0);} }while(0)
  for(;t+1<NT;t+=2){
    STEP(pB0,pB1,pA0,pA1,t,(t+3<NT),(t+1<NT),(t+1<NT));       ENDW(t);   RESC(); ROT();
    STEP(pA0,pA1,pB0,pB1,t+1,(t+4<NT),(t+2<NT),(t+2<NT));     ENDW(t+1); RESC(); ROT();
  }
  STEP(pB0,pB1,pA0,pA1,NT-1,false,false,false); RESC();
  { float sacc=pB0[0]+pB0[1]; _Pragma("unroll") for(int r=2;r<16;++r)sacc+=pB0[r]; _Pragma("unroll") for(int r=0;r<16;++r)sacc+=pB1[r]; l_reg+=sacc;
    pw0=(u32x4){PKW(pB0,0),PKW(pB0,2),PKW(pB0,4),PKW(pB0,6)};pw1=(u32x4){PKW(pB0,8),PKW(pB0,10),PKW(pB0,12),PKW(pB0,14)};pw2=(u32x4){PKW(pB1,0),PKW(pB1,2),PKW(pB1,4),PKW(pB1,6)};pw3=(u32x4){PKW(pB1,8),PKW(pB1,10),PKW(pB1,12),PKW(pB1,14)};
    SBAR(); pv(o,vb0+sl_cur,PAF(0),PAF(1),PAF(2),PAF(3)); }
  #undef PKW
  #undef PAF
  #undef VFR
  #undef PIN
  #undef MX3
  #undef GAPA
  #undef GAPB
  #undef EX
  #undef VRD
  #undef KRD
  #undef STEP
  #undef ENDW
  {auto rr=__builtin_amdgcn_permlane32_swap(__float_as_uint(l_reg),__float_as_uint(l_reg),false,false);l_reg=__uint_as_float(rr[0])+__uint_as_float(rr[1]);}
  if(hi==0)wsf[32+r32]=l_reg;asm volatile("s_waitcnt lgkmcnt(0)":::"memory");
  if(ML!=nullptr&&hi==0){ML[2*(wid*QBLK+r32)]=mhat;ML[2*(wid*QBLK+r32)+1]=l_reg;}
  float rli[16];
  #pragma unroll
  for(int r=0;r<16;++r)rli[r]=__builtin_amdgcn_rcpf(wsf[32+crow(r,hi)]);
  bf16*Ow=Ow0+(long)(wid*QBLK)*OP;
  { bf16*stg=(bf16*)(shm+LDS_OST)+wid*2048;
    #pragma unroll
    for(int r=0;r<16;++r){const int orow=crow(r,hi);
      #pragma unroll
      for(int d0=0;d0<2;++d0)stg[orow*64+d0*32+r32]=__float2bfloat16(o[d0][r]*rli[r]);}
    asm volatile("s_waitcnt lgkmcnt(0)":::"memory");
    #pragma unroll
    for(int i=0;i<4;++i){const int row=i*8+(lane>>3),ch=lane&7; const u32x4 v=*(const u32x4*)(stg+row*64+ch*8); ATTN_STORE16(Ow+(long)row*OP+ch*8,v);} }
  asm volatile("s_waitcnt lgkmcnt(0)\n\ts_barrier":::"memory");
  #undef DMA_K
  #undef DMA_V
  #undef CMASK
  #undef START
  #undef RESC
  #undef ROT
}
constexpr int ATTN_LDS_BYTES=LDS_BYTES;
#undef SBAR
#undef WAIT_BAR
}

__device__ __forceinline__ void ph_attn(int wv, int layer, LAS unsigned char* lds) {
    const Params p = load_params();
    PHASE_IDS();
    const int tid = tid_;
    const attn_body::bf16* QB = (const attn_body::bf16*)(p.ws + OFF_QB); const attn_body::bf16* KB = (const attn_body::bf16*)(p.ws + OFF_KB); const attn_body::bf16* VN = (const attn_body::bf16*)(p.ws + OFF_VT);
    attn_body::bf16* Y = (attn_body::bf16*)(p.ws + OFF_Y);
    constexpr int NFULL = 512 - ATT_NSU, NSPLIT = ATT_NSU * 3;
    attn_body::bf16* PO = (attn_body::bf16*)(p.ws + OFF_APO); float* AML = (float*)(p.ws + OFF_AML);
    const int nunits = NFULL + NSPLIT + (layer == 0 ? 16 : 0);
    unsigned* qctr = (unsigned*)(p.ws + OFF_CTL) + 64 * (1 + layer);
    LAS int* su = (LAS int*)(lds + 90112);
    static_assert(attn_body::ATTN_LDS_BYTES <= 90112, "attention LDS map");
    for (;;) {
        __syncthreads();
        if (tid == 0) *su = (int)atomicAdd(qctr, 1u);
        __syncthreads();
        const int u = *su;
        if (u >= nunits) break;
        int b, h, row0, nkt, kt0 = 0, combo = -1;
        if (u < NFULL) { b = u >> 8; h = (u >> 5) & 7; row0 = b * SEQ + (u & 31) * 256; nkt = KPOS / 64; }
        else if (u < NFULL + NSPLIT) { combo = u - NFULL; const int fu = NFULL + combo / 3; b = fu >> 8; h = (fu >> 5) & 7; row0 = b * SEQ + (fu & 31) * 256; nkt = KPOS / 64 / 3; kt0 = (combo % 3) * nkt; }
        else { const int v = u - NFULL - NSPLIT; b = v >> 3; h = v & 7; row0 = NLAT + b * CTXL; nkt = CTXL / 64; }
        const int g = h >> 2;
        const attn_body::bf16* Kh = KB + ((size_t)(b * 2 + g) * KPOS + (size_t)kt0 * 64) * 64;
        const attn_body::bf16* Vh = VN + ((size_t)(b * 2 + g) * KPOS + (size_t)kt0 * 64) * 64;
        if (combo < 0) attn_body::attn_unit<8>(tid, nkt, QB + (size_t)row0 * 512 + h * 64, Kh, Vh, Y + (size_t)row0 * DM + h * 64, (char*)lds);
        else attn_body::attn_unit<8>(tid, nkt, QB + (size_t)row0 * 512 + h * 64, Kh, Vh, PO + (size_t)(combo >> 4) * 256 * DM + (combo & 15) * 64, (char*)lds, AML + (size_t)combo * 512);
    }
}

__device__ __forceinline__ int scan_row(int step, int b, int dir, bool& is_ctx) {
    if (step < CTXL) { is_ctx = true; const int m = dir ? CTXL - 1 - step : step; return NLAT + b * CTXL + m; }
    is_ctx = false; const int n = step - CTXL; return b * SEQ + (dir ? SEQ - 1 - n : n);
}
__device__ __forceinline__ void ph_scan(int wv, int layer) {
    const Params p = load_params();
    int wv_ = __builtin_amdgcn_readfirstlane(wv); asm volatile("" : "+s"(wv_)); int tid_; { int l_; asm volatile("v_mbcnt_lo_u32_b32 %0, -1, 0\n\tv_mbcnt_hi_u32_b32 %0, -1, %0" : "=v"(l_)); tid_ = wv_ * 64 + l_; } int bid_ = blockIdx.x; asm volatile("" : "+s"(bid_)); int nblk_ = gridDim.x; asm volatile("" : "+s"(nblk_));
    if (tid_ >= 64) return;
    const int lane = tid_;
    if ((bid_ & 7) != 0) return;
    const int chain = bid_ >> 3;
    if (chain >= 32) return;
    const int kind = chain >> 4, b = (chain >> 3) & 1, h = (chain >> 1) & 3, dir = chain & 1;
    const bf16_t* P = (const bf16_t*)(p.ws + OFF_PB);
    const float* G = (const float*)(p.ws + OFF_G);
    if (kind == 0) {
        float* MLH = (float*)(p.ws + OFF_MLH) + (size_t)dir * NROW * 256;
        const float ib = p.in[I_MLIB][layer * 8 + dir * 4 + h], fb = p.in[I_MLFB][layer * 8 + dir * 4 + h];
        float C[64];
#pragma unroll
        for (int i = 0; i < 64; ++i) C[i] = 0.f;
        float nvec = 0.f, mrun = 0.f;
        bool ic; int r = scan_row(0, b, dir, ic);
        float q = bf2f(P[(size_t)r * NPC + 768 + h * 64 + lane]), k = bf2f(P[(size_t)r * NPC + 1024 + h * 64 + lane]) * 0.125f, v = bf2f(P[(size_t)r * NPC + 1280 + h * 64 + lane]);
        float ig = G[(size_t)r * NGC + dir * 4 + h] + ib, fg = G[(size_t)r * NGC + 8 + dir * 4 + h] + fb;
        for (int step = 0; step < KPOS; ++step) {
            const int rcur = r; const bool iccur = ic;
            const float qc = q, kc = k, vc = v, igc = ig, fgc = fg;
            if (step + 1 < KPOS) {
                r = scan_row(step + 1, b, dir, ic);
                q = bf2f(P[(size_t)r * NPC + 768 + h * 64 + lane]); k = bf2f(P[(size_t)r * NPC + 1024 + h * 64 + lane]) * 0.125f; v = bf2f(P[(size_t)r * NPC + 1280 + h * 64 + lane]);
                ig = G[(size_t)r * NGC + dir * 4 + h] + ib; fg = G[(size_t)r * NGC + 8 + dir * 4 + h] + fb;
            }
            const float lf = logsigmoidf_(fgc);
            const float mnew = fmaxf(lf + mrun, igc);
            const float fd = expf(lf + mrun - mnew), iw = expf(igc - mnew);
            mrun = mnew;
            nvec = fd * nvec + iw * kc;
            const float den = wave_sum(nvec * qc);
            const float wv = iw * vc;
            float num0 = 0.f, num1 = 0.f;
#pragma unroll
            for (int i = 0; i < 64; i += 2) {
                C[i] = fd * C[i] + rdlane(kc, i) * wv; num0 += rdlane(qc, i) * C[i];
                C[i + 1] = fd * C[i + 1] + rdlane(kc, i + 1) * wv; num1 += rdlane(qc, i + 1) * C[i + 1];
            }
            const float hh = (num0 + num1) / fmaxf(fabsf(den), expf(-mnew));
            if (!iccur || layer == 0) MLH[(size_t)rcur * 256 + h * 64 + lane] = hh;
        }
    } else {
        float* GDO = (float*)(p.ws + OFF_GDO) + (size_t)dir * NROW * 256;
        const bf16_t* GQ = (const bf16_t*)(p.ws + OFF_GQB); const bf16_t* GK = (const bf16_t*)(p.ws + OFF_GKB); const bf16_t* GV = (const bf16_t*)(p.ws + OFF_GVB);
        const float Aneg = -expf(p.in[I_GAL][layer * 8 + dir * 4 + h]), dtb = p.in[I_GDT][layer * 8 + dir * 4 + h];
        float S[64];
#pragma unroll
        for (int i = 0; i < 64; ++i) S[i] = 0.f;
        bool ic; int r = scan_row(0, b, dir, ic);
        float q = bf2f(GQ[(size_t)r * 256 + h * 64 + lane]), k = bf2f(GK[(size_t)r * 256 + h * 64 + lane]), v = bf2f(GV[(size_t)r * 256 + h * 64 + lane]);
        float ag = G[(size_t)r * NGC + 16 + dir * 4 + h], bg = G[(size_t)r * NGC + 24 + dir * 4 + h];
        for (int step = 0; step < KPOS; ++step) {
            const int rcur = r; const bool iccur = ic;
            const float qc = q, kc = k, vc = v, agc = ag, bgc = bg;
            if (step + 1 < KPOS) {
                r = scan_row(step + 1, b, dir, ic);
                q = bf2f(GQ[(size_t)r * 256 + h * 64 + lane]); k = bf2f(GK[(size_t)r * 256 + h * 64 + lane]); v = bf2f(GV[(size_t)r * 256 + h * 64 + lane]);
                ag = G[(size_t)r * NGC + 16 + dir * 4 + h]; bg = G[(size_t)r * NGC + 24 + dir * 4 + h];
            }
            const float alpha = expf(Aneg * softplusf_(agc + dtb));
            const float beta = sigmoidf_(bgc);
            float r0 = 0.f, r1 = 0.f;
#pragma unroll
            for (int i = 0; i < 64; i += 2) { S[i] *= alpha; r0 += S[i] * rdlane(kc, i); S[i + 1] *= alpha; r1 += S[i + 1] * rdlane(kc, i + 1); }
            const float vn = beta * (vc - (r0 + r1));
            float o0 = 0.f, o1 = 0.f;
#pragma unroll
            for (int i = 0; i < 64; i += 2) { S[i] += rdlane(kc, i) * vn; o0 += S[i] * rdlane(qc, i); S[i + 1] += rdlane(kc, i + 1) * vn; o1 += S[i + 1] * rdlane(qc, i + 1); }
            if (!iccur || layer == 0) GDO[(size_t)rcur * 256 + h * 64 + lane] = o0 + o1;
        }
    }
}

__device__ __forceinline__ void fnma_asm(float& acc, float a, float b) { asm("v_fma_f32 %0, -%1, %2, %0" : "+v"(acc) : "v"(a), "v"(b)); }
__device__ __forceinline__ void pk_fnma_lo(f32x2& acc, const f32x2 xk, const f32x2 a) { asm("v_pk_fma_f32 %0, %1, %2, %0 op_sel:[0,0,0] op_sel_hi:[0,1,1] neg_lo:[1,0,0] neg_hi:[1,0,0]" : "+v"(acc) : "v"(xk), "v"(a)); }
__device__ __forceinline__ void pk_fnma_hi(f32x2& acc, const f32x2 xk, const f32x2 a) { asm("v_pk_fma_f32 %0, %1, %2, %0 op_sel:[1,0,0] op_sel_hi:[1,1,1] neg_lo:[1,0,0] neg_hi:[1,0,0]" : "+v"(acc) : "v"(xk), "v"(a)); }
__device__ __forceinline__ f32x16 mfma32(bf16x8 a, bf16x8 b, f32x16 c) { return __builtin_amdgcn_mfma_f32_32x32x16_bf16(a, b, c, 0, 0, 0); }
template <int U> __device__ __forceinline__ bf16x8 acc_frag(const f32x16& a) {
    u32x4 w; w.x = pk_bf16(a[8 * U + 0], a[8 * U + 1]); w.y = pk_bf16(a[8 * U + 2], a[8 * U + 3]); w.z = pk_bf16(a[8 * U + 4], a[8 * U + 5]); w.w = pk_bf16(a[8 * U + 6], a[8 * U + 7]);
    return __builtin_bit_cast(bf16x8, w);
}
__device__ __forceinline__ bf16x8 gather_lds(const LAS bf16_t* tile, int ks, int hi, int col) {
    const LAS bf16_t* b = tile + (4 * hi) * 64 + col; bf16x8 f;
#pragma unroll
    for (int j = 0; j < 8; ++j) f[j] = (short)b[(16 * ks + 8 * (j >> 2) + (j & 3)) * 64];
    return f;
}
template <int U> __device__ __forceinline__ bf16x8 acc_frag_s(const f32x16& a, const float (&s)[16]) {
    u32x4 w; w.x = pk_bf16(a[8 * U + 0] * s[8 * U + 0], a[8 * U + 1] * s[8 * U + 1]); w.y = pk_bf16(a[8 * U + 2] * s[8 * U + 2], a[8 * U + 3] * s[8 * U + 3]);
    w.z = pk_bf16(a[8 * U + 4] * s[8 * U + 4], a[8 * U + 5] * s[8 * U + 5]); w.w = pk_bf16(a[8 * U + 6] * s[8 * U + 6], a[8 * U + 7] * s[8 * U + 7]);
    return __builtin_bit_cast(bf16x8, w);
}
__device__ __forceinline__ bf16x8 mk_frag(u32x2 lo, u32x2 hi8) { return __builtin_bit_cast(bf16x8, (u32x4){lo.x, lo.y, hi8.x, hi8.y}); }
__device__ __forceinline__ bf16x8 ld_perm(const bf16_t* rowk0, int hi) { return mk_frag(*(const u32x2*)(rowk0 + 4 * hi), *(const u32x2*)(rowk0 + 8 + 4 * hi)); }
__device__ __forceinline__ float bperm(float v, int srclane) { return __builtin_bit_cast(float, __builtin_amdgcn_ds_bpermute(srclane << 2, __builtin_bit_cast(int, v))); }
__device__ __forceinline__ float scan_add64(float v, int lane) {
#pragma unroll
    for (int o = 1; o < 64; o <<= 1) { const float t = bperm(v, lane - o); if (lane >= o) v += t; }
    return v;
}
__device__ __forceinline__ float scan_max64(float v, int lane) {
#pragma unroll
    for (int o = 1; o < 64; o <<= 1) { const float t = bperm(v, lane - o); if (lane >= o) v = fmaxf(v, t); }
    return v;
}
struct ChunkRows { int r0, sgn; };
__device__ __forceinline__ ChunkRows chunk_rows(int b, int dir, int c) {
    ChunkRows cr; cr.sgn = dir ? -1 : 1;
    if (c < 4) cr.r0 = NLAT + b * CTXL + (dir ? CTXL - 1 - 64 * c : 64 * c);
    else cr.r0 = b * SEQ + (dir ? SEQ - 1 - 64 * (c - 4) : 64 * (c - 4));
    return cr;
}
__device__ __forceinline__ bf16x8 gather_perm(const bf16_t* base, int ld, ChunkRows cr, int ks, int hi, int col) {
    bf16x8 f;
#pragma unroll
    for (int j = 0; j < 8; ++j) { const int tau = 16 * ks + 8 * (j >> 2) + 4 * hi + (j & 3); f[j] = (short)base[(size_t)(cr.r0 + cr.sgn * tau) * ld + col]; }
    return f;
}
__device__ __forceinline__ void st_frag(GAS float* dst, int lane, const f32x16& a) {
    GAS float* d = dst + lane * 4;
#pragma unroll
    for (int q = 0; q < 4; ++q) *(GAS f32x4*)(d + 256 * q) = (f32x4){a[4 * q], a[4 * q + 1], a[4 * q + 2], a[4 * q + 3]};
}
__device__ __forceinline__ f32x16 ld_frag(const GAS float* src, int lane) {
    const GAS float* d = src + lane * 4; f32x16 a;
#pragma unroll
    for (int q = 0; q < 4; ++q) { const f32x4 v = *(const GAS f32x4*)(d + 256 * q); a[4 * q] = v.x; a[4 * q + 1] = v.y; a[4 * q + 2] = v.z; a[4 * q + 3] = v.w; }
    return a;
}
__device__ __forceinline__ void ld_rowvec_lds(const LAS float* vec, int blk, int hi, float (&out)[16]) {
#pragma unroll
    for (int q = 0; q < 4; ++q) { const f32x4 v = *(const LAS f32x4*)(vec + 32 * blk + 8 * q + 4 * hi); out[4 * q] = v.x; out[4 * q + 1] = v.y; out[4 * q + 2] = v.z; out[4 * q + 3] = v.w; }
}
__device__ __forceinline__ void ld_rowvec_g(const float* vec, int blk, int hi, float (&out)[16]) {
#pragma unroll
    for (int q = 0; q < 4; ++q) { const f32x4 v = *(const f32x4*)(vec + 32 * blk + 8 * q + 4 * hi); out[4 * q] = v.x; out[4 * q + 1] = v.y; out[4 * q + 2] = v.z; out[4 * q + 3] = v.w; }
}

__device__ __forceinline__ float fexp(float x) { return __builtin_amdgcn_exp2f(x * 1.4426950408889634f); }
__device__ __forceinline__ void mlstm_A_unit(const Params& p, int layer, int chain, int c, int lane_in, LAS float* wl) {
    int lane = lane_in; asm volatile("" : "+v"(lane));
    const int b = chain >> 3, h = (chain >> 1) & 3, dir = chain & 1, r_ = lane & 31, hi = lane >> 5;
    const ChunkRows cr = chunk_rows(b, dir, c);
    const bf16_t* Pb = (const bf16_t*)(p.ws + OFF_PB);
    const float* G = (const float*)(p.ws + OFF_G);
    const int uid = chain * NCHUNK + c;
    float* VEC = (float*)(p.ws + OFF_MLVEC) + (size_t)uid * 320;
    GAS float* NUM = (GAS float*)(p.ws + OFF_MLNUM) + (size_t)uid * 4096;
    GAS float* KL = (GAS float*)(p.ws + OFF_MLKL) + (size_t)uid * 4096;
    const int rt = cr.r0 + cr.sgn * lane;
    const float ig = G[(size_t)rt * NGC + dir * 4 + h] + p.in[I_MLIB][layer * 8 + dir * 4 + h];
    const float fg = G[(size_t)rt * NGC + 8 + dir * 4 + h] + p.in[I_MLFB][layer * 8 + dir * 4 + h];
    const float bb = scan_add64(logsigmoidf_(fg), lane);
    const float cc = ig - bb;
    const float gcm = scan_max64(cc, lane);
    const float Btot = rdlane(bb, 63), gmax = rdlane(gcm, 63);
    wl[lane] = cc; wl[64 + lane] = gcm; wl[128 + lane] = fexp(cc - gmax) * 0.125f;
    VEC[128 + lane] = bb + gcm; VEC[192 + lane] = bb;
    if (lane == 0) { VEC[256] = Btot + gmax; VEC[257] = Btot; }
    f32x16 X[2][2];
    {
        bf16x8 Kf[2][4], Qf[2][4];
#pragma unroll
        for (int blk = 0; blk < 2; ++blk)
#pragma unroll
            for (int ks = 0; ks < 4; ++ks) {
                const bf16_t* rp = Pb + (size_t)(cr.r0 + cr.sgn * (32 * blk + r_)) * NPC + h * 64 + 16 * ks + 8 * hi;
                Kf[blk][ks] = *(const bf16x8*)(rp + 1024); Qf[blk][ks] = *(const bf16x8*)(rp + 768);
            }
#pragma unroll
        for (int sb = 0; sb < 2; ++sb)
#pragma unroll
            for (int tb = 0; tb < 2; ++tb) {
                f32x16 a = {};
#pragma unroll
                for (int ks = 0; ks < 4; ++ks) a = mfma32(Kf[sb][ks], Qf[tb][ks], a);
                X[sb][tb] = a;
            }
        GAS u32x4* QP = (GAS u32x4*)(p.ws + OFF_MLQP) + (size_t)uid * 512;
#pragma unroll
        for (int tb = 0; tb < 2; ++tb)
#pragma unroll
            for (int ks = 0; ks < 4; ++ks) {
                const u32x4 nat = __builtin_bit_cast(u32x4, Qf[tb][ks]);
                auto s02 = __builtin_amdgcn_permlane32_swap(nat.x, nat.z, false, false);
                auto s13 = __builtin_amdgcn_permlane32_swap(nat.y, nat.w, false, false);
                QP[(tb * 4 + ks) * 64 + lane] = (u32x4){s02[0], s13[0], s02[1], s13[1]};
            }
    }
#pragma unroll
    for (int tb = 0; tb < 2; ++tb) {
        const int t = 32 * tb + r_; const float gt = wl[64 + t]; float dsum = 0.f;
#pragma unroll
        for (int sb = 0; sb < 2; ++sb) {
            float cs[16]; ld_rowvec_lds(wl, sb, hi, cs);
#pragma unroll
            for (int g = 0; g < 16; ++g) {
                const int s = 32 * sb + (g & 3) + 8 * (g >> 2) + 4 * hi;
                const float w = (s <= t) ? fexp(cs[g] - gt) * 0.125f : 0.f;
                X[sb][tb][g] *= w; dsum += X[sb][tb][g];
            }
        }
        dsum += xor_lane<32>(dsum);
        if (hi == 0) VEC[64 + t] = dsum;
    }
    bf16x8 Vg[2][4];
#pragma unroll
    for (int db = 0; db < 2; ++db)
#pragma unroll
        for (int ks = 0; ks < 4; ++ks) Vg[db][ks] = gather_perm(Pb, NPC, cr, ks, hi, 1280 + h * 64 + 32 * db + r_);
#pragma unroll
    for (int tb = 0; tb < 2; ++tb)
#pragma unroll
        for (int db = 0; db < 2; ++db) {
            f32x16 a = {};
            a = mfma32(acc_frag<0>(X[0][tb]), Vg[db][0], a); a = mfma32(acc_frag<1>(X[0][tb]), Vg[db][1], a);
            a = mfma32(acc_frag<0>(X[1][tb]), Vg[db][2], a); a = mfma32(acc_frag<1>(X[1][tb]), Vg[db][3], a);
            st_frag(NUM + (tb * 2 + db) * 1024, lane, a);
        }
#pragma unroll
    for (int kb = 0; kb < 2; ++kb) {
        bf16x8 Af[4]; float nl = 0.f;
#pragma unroll
        for (int ks = 0; ks < 4; ++ks) {
            const bf16x8 raw = gather_perm(Pb, NPC, cr, ks, hi, 1024 + h * 64 + 32 * kb + r_);
            const f32x4 a0 = *(const LAS f32x4*)(wl + 128 + 16 * ks + 4 * hi), a1 = *(const LAS f32x4*)(wl + 128 + 16 * ks + 8 + 4 * hi);
            float e[8];
#pragma unroll
            for (int j = 0; j < 4; ++j) { e[j] = bf2f((bf16_t)raw[j]) * a0[j]; e[4 + j] = bf2f((bf16_t)raw[4 + j]) * a1[j]; }
#pragma unroll
            for (int j = 0; j < 8; ++j) nl += e[j];
            u32x4 w; w.x = pk_bf16(e[0], e[1]); w.y = pk_bf16(e[2], e[3]); w.z = pk_bf16(e[4], e[5]); w.w = pk_bf16(e[6], e[7]);
            Af[ks] = __builtin_bit_cast(bf16x8, w);
        }
        nl += xor_lane<32>(nl);
        if (hi == 0) VEC[32 * kb + r_] = nl;
#pragma unroll
        for (int db = 0; db < 2; ++db) {
            f32x16 a = {};
#pragma unroll
            for (int ks = 0; ks < 4; ++ks) a = mfma32(Af[ks], Vg[db][ks], a);
            st_frag(KL + (kb * 2 + db) * 1024, lane, a);
        }
    }
}

__device__ __forceinline__ void gdn_A_unit(const Params& p, int layer, int chain, int c, int lane_in, LAS float* wl) {
    int lane = lane_in; asm volatile("" : "+v"(lane));
    const int b = chain >> 3, h = (chain >> 1) & 3, dir = chain & 1, r_ = lane & 31, hi = lane >> 5;
    const ChunkRows cr = chunk_rows(b, dir, c);
    const bf16_t* GQ = (const bf16_t*)(p.ws + OFF_GQB); const bf16_t* GK = (const bf16_t*)(p.ws + OFF_GKB); const bf16_t* GV = (const bf16_t*)(p.ws + OFF_GVB);
    const float* G = (const float*)(p.ws + OFF_G);
    const int uid = chain * NCHUNK + c;
    GAS bf16_t* MW = (GAS bf16_t*)(p.ws + OFF_GDMW) + (size_t)uid * 4096;
    GAS float* NM = (GAS float*)(p.ws + OFF_GDN) + (size_t)uid * 4096;
    GAS bf16_t* QE = (GAS bf16_t*)(p.ws + OFF_GDQE) + (size_t)uid * 4096;
    GAS float* OL = (GAS float*)(p.ws + OFF_GDOL) + (size_t)uid * 4096;
    LAS float* AL = wl + 192;
    LAS bf16_t* PmL = (LAS bf16_t*)(wl + 192);
    const int rt = cr.r0 + cr.sgn * lane;
    const float gl = -fexp(p.in[I_GAL][layer * 8 + dir * 4 + h]) * softplusf_(G[(size_t)rt * NGC + 16 + dir * 4 + h] + p.in[I_GDT][layer * 8 + dir * 4 + h]);
    const float beta = sigmoidf_(G[(size_t)rt * NGC + 24 + dir * 4 + h]);
    const float Gc = scan_add64(gl, lane);
    const float Glast = rdlane(Gc, 63);
    wl[lane] = Gc; wl[64 + lane] = fexp(Glast - Gc); wl[128 + lane] = beta;
    if (lane == 0) ((float*)(p.ws + OFF_GDSC))[uid] = fexp(Glast);
    f32x2 xp[32];
    {
        f32x16 KK[2][2];
        {
            bf16x8 Kr[2][4];
#pragma unroll
            for (int blk = 0; blk < 2; ++blk)
#pragma unroll
                for (int ks = 0; ks < 4; ++ks) Kr[blk][ks] = *(const bf16x8*)(GK + (size_t)(cr.r0 + cr.sgn * (32 * blk + r_)) * 256 + h * 64 + 16 * ks + 8 * hi);
#pragma unroll
            for (int ib = 0; ib < 2; ++ib)
#pragma unroll
                for (int jb = 0; jb < 2; ++jb) {
                    f32x16 a = {};
#pragma unroll
                    for (int ks = 0; ks < 4; ++ks) a = mfma32(Kr[ib][ks], Kr[jb][ks], a);
                    KK[ib][jb] = a;
                }
        }
#pragma unroll
        for (int ib = 0; ib < 2; ++ib) {
            float Gi[16], bi[16]; ld_rowvec_lds(wl, ib, hi, Gi); ld_rowvec_lds(wl + 128, ib, hi, bi);
#pragma unroll
            for (int jb = 0; jb < 2; ++jb) {
                const int j = 32 * jb + r_; const float Gj = wl[j];
#pragma unroll
                for (int g = 0; g < 16; ++g)
                    AL[(32 * ib + (g & 3) + 8 * (g >> 2) + 4 * hi) * 68 + j] = KK[ib][jb][g] * bi[g] * fexp(fminf(Gi[g] - Gj, 0.f));
            }
        }
#pragma unroll
        for (int j = 0; j < 32; ++j) xp[j] = (f32x2){(lane == 2 * j) ? 1.f : 0.f, (lane == 2 * j + 1) ? 1.f : 0.f};
#pragma unroll
        for (int k = 63; k >= 1; --k) {
#pragma unroll
            for (int j4 = 0; j4 < k; j4 += 4) {
                const f32x4 a = *(const volatile LAS f32x4*)(AL + k * 68 + j4);
                const f32x2 xk = xp[k >> 1];
#pragma unroll
                for (int h2 = 0; h2 < 2; ++h2) {
                    const int j = j4 + 2 * h2;
                    const f32x2 ap = h2 ? (f32x2){a.z, a.w} : (f32x2){a.x, a.y};
                    if (j + 1 < k) { if (k & 1) pk_fnma_hi(xp[j >> 1], xk, ap); else pk_fnma_lo(xp[j >> 1], xk, ap); }
                    else if (j < k) { float t = xp[j >> 1].x; fnma_asm(t, xk.y, ap.x); xp[j >> 1].x = t; }
                }
            }
            __builtin_amdgcn_sched_barrier(0);
        }
    }
    __builtin_amdgcn_sched_barrier(0);
    unsigned tbd[32];
#pragma unroll
    for (int d = 0; d < 32; ++d) {
        tbd[d] = pk_bf16(xp[d].x * wl[128 + 2 * d], xp[d].y * wl[128 + 2 * d + 1]);
    }
    __builtin_amdgcn_sched_barrier(0);
    LAS bf16_t* KtL = (LAS bf16_t*)AL; LAS bf16_t* VtL = KtL + 4096;
    {
        const bf16_t* GK2 = GK; const bf16_t* GV2 = GV; asm volatile("" : "+s"(GK2), "+s"(GV2));
        const GAS bf16_t* gk = (const GAS bf16_t*)GK2; const GAS bf16_t* gv = (const GAS bf16_t*)GV2;
#pragma unroll
        for (int i = 0; i < 8; ++i) {
            const int row = i * 8 + (lane >> 3), ch = lane & 7;
            const size_t go = (size_t)(cr.r0 + cr.sgn * row) * 256 + h * 64 + ch * 8;
            *(LAS u32x4*)(KtL + row * 64 + ch * 8) = *(const GAS u32x4*)(gk + go);
            *(LAS u32x4*)(VtL + row * 64 + ch * 8) = *(const GAS u32x4*)(gv + go);
        }
    }
    constexpr int LO[4] = {0, 1, 4, 5}, HI[4] = {2, 3, 6, 7};
    bf16x8 Uf[2][4], Wf[2][4];
#pragma unroll
    for (int db = 0; db < 2; ++db) {
        f32x16 U0 = {}, U1 = {};
#pragma unroll
        for (int ks = 0; ks < 4; ++ks) {
            u32x4 f0, f1;
#pragma unroll
            for (int q = 0; q < 4; ++q) { auto rb = __builtin_amdgcn_permlane32_swap(tbd[8 * ks + LO[q]], tbd[8 * ks + HI[q]], false, false); f0[q] = rb[0]; f1[q] = rb[1]; }
            const bf16x8 Vp = gather_lds(VtL, ks, hi, 32 * db + r_);
            U0 = mfma32(__builtin_bit_cast(bf16x8, f0), Vp, U0); U1 = mfma32(__builtin_bit_cast(bf16x8, f1), Vp, U1);
        }
        float el0[16], el1[16]; ld_rowvec_lds(wl + 64, 0, hi, el0); ld_rowvec_lds(wl + 64, 1, hi, el1);
        const bf16x8 s0 = acc_frag_s<0>(U0, el0), s1 = acc_frag_s<1>(U0, el0), s2 = acc_frag_s<0>(U1, el1), s3 = acc_frag_s<1>(U1, el1);
#pragma unroll
        for (int kb = 0; kb < 2; ++kb) {
            f32x16 n = {};
            n = mfma32(gather_lds(KtL, 0, hi, 32 * kb + r_), s0, n); n = mfma32(gather_lds(KtL, 1, hi, 32 * kb + r_), s1, n);
            n = mfma32(gather_lds(KtL, 2, hi, 32 * kb + r_), s2, n); n = mfma32(gather_lds(KtL, 3, hi, 32 * kb + r_), s3, n);
            st_frag(NM + (kb * 2 + db) * 1024, lane, n);
        }
        Uf[db][0] = acc_frag<0>(U0); Uf[db][1] = acc_frag<1>(U0); Uf[db][2] = acc_frag<0>(U1); Uf[db][3] = acc_frag<1>(U1);
        __builtin_amdgcn_sched_barrier(0);
    }
#pragma unroll
    for (int i = 0; i < 8; ++i) {
        const int row = i * 8 + (lane >> 3), ch = lane & 7;
        const bf16x8 kv = *(const LAS bf16x8*)(KtL + row * 64 + ch * 8);
        const float sc = fexp(wl[row]);
        u32x4 o;
        o.x = pk_bf16(bf2f((bf16_t)kv[0]) * sc, bf2f((bf16_t)kv[1]) * sc); o.y = pk_bf16(bf2f((bf16_t)kv[2]) * sc, bf2f((bf16_t)kv[3]) * sc);
        o.z = pk_bf16(bf2f((bf16_t)kv[4]) * sc, bf2f((bf16_t)kv[5]) * sc); o.w = pk_bf16(bf2f((bf16_t)kv[6]) * sc, bf2f((bf16_t)kv[7]) * sc);
        *(LAS u32x4*)(VtL + row * 64 + ch * 8) = o;
    }
#pragma unroll
    for (int db = 0; db < 2; ++db) {
        f32x16 W0 = {}, W1 = {};
#pragma unroll
        for (int ks = 0; ks < 4; ++ks) {
            u32x4 f0, f1;
#pragma unroll
            for (int q = 0; q < 4; ++q) { auto rg = __builtin_amdgcn_permlane32_swap(tbd[8 * ks + LO[q]], tbd[8 * ks + HI[q]], false, false); f0[q] = rg[0]; f1[q] = rg[1]; }
            const bf16x8 Kp = gather_lds(VtL, ks, hi, 32 * db + r_);
            W0 = mfma32(__builtin_bit_cast(bf16x8, f0), Kp, W0); W1 = mfma32(__builtin_bit_cast(bf16x8, f1), Kp, W1);
        }
        float el0[16], el1[16]; ld_rowvec_lds(wl + 64, 0, hi, el0); ld_rowvec_lds(wl + 64, 1, hi, el1);
        const bf16x8 s0 = acc_frag_s<0>(W0, el0), s1 = acc_frag_s<1>(W0, el0), s2 = acc_frag_s<0>(W1, el1), s3 = acc_frag_s<1>(W1, el1);
#pragma unroll
        for (int kbp = 0; kbp < 2; ++kbp) {
            f32x16 a = {};
            a = mfma32(gather_lds(KtL, 0, hi, 32 * kbp + r_), s0, a); a = mfma32(gather_lds(KtL, 1, hi, 32 * kbp + r_), s1, a);
            a = mfma32(gather_lds(KtL, 2, hi, 32 * kbp + r_), s2, a); a = mfma32(gather_lds(KtL, 3, hi, 32 * kbp + r_), s3, a);
            GAS bf16_t* mwb = MW + ((kbp * 4 + 2 * db + (r_ >> 4)) * 64 + 32 * ((r_ >> 2) & 1) + 4 * hi) * 8 + 4 * ((r_ >> 3) & 1) + (r_ & 3);
#pragma unroll
            for (int g = 0; g < 16; ++g) mwb[((g & 3) + 8 * (g >> 2)) * 8] = f2bf(-a[g]);
        }
        Wf[db][0] = acc_frag<0>(W0); Wf[db][1] = acc_frag<1>(W0); Wf[db][2] = acc_frag<0>(W1); Wf[db][3] = acc_frag<1>(W1);
        __builtin_amdgcn_sched_barrier(0);
    }
    LAS bf16x8* WfL = (LAS bf16x8*)((LAS bf16_t*)AL + 4352);
#pragma unroll
    for (int db = 0; db < 2; ++db)
#pragma unroll
        for (int ks = 0; ks < 4; ++ks) WfL[(db * 4 + ks) * 64 + lane] = Wf[db][ks];
    __builtin_amdgcn_sched_barrier(0);
    const GAS bf16_t* gq;
    { const bf16_t* GQ3 = GQ; asm volatile("" : "+s"(GQ3)); gq = (const GAS bf16_t*)GQ3; }
    {
        bf16x8 Kr[2][4];
#pragma unroll
        for (int blk = 0; blk < 2; ++blk)
#pragma unroll
            for (int ks = 0; ks < 4; ++ks) Kr[blk][ks] = *(const LAS bf16x8*)(KtL + (32 * blk + r_) * 64 + 16 * ks + 8 * hi);
        __builtin_amdgcn_sched_barrier(0);
#pragma unroll
        for (int tb = 0; tb < 2; ++tb) {
            bf16x8 Qr[4];
#pragma unroll
            for (int ks = 0; ks < 4; ++ks) Qr[ks] = *(const GAS bf16x8*)(gq + (size_t)(cr.r0 + cr.sgn * (32 * tb + r_)) * 256 + h * 64 + 16 * ks + 8 * hi);
            float Gt[16]; ld_rowvec_lds(wl, tb, hi, Gt);
#pragma unroll
            for (int sb = 0; sb < 2; ++sb) {
                f32x16 a = {};
#pragma unroll
                for (int ks = 0; ks < 4; ++ks) a = mfma32(Qr[ks], Kr[sb][ks], a);
                const int s = 32 * sb + r_; const float Gs = wl[s];
#pragma unroll
                for (int g = 0; g < 16; ++g) {
                    const int t = 32 * tb + (g & 3) + 8 * (g >> 2) + 4 * hi;
                    const float v = (s <= t) ? a[g] * fexp(fminf(Gt[g] - Gs, 0.f)) : 0.f;
                    PmL[t * 68 + s] = f2bf(v);
                }
            }
            __builtin_amdgcn_sched_barrier(0);
        }
    }
    __builtin_amdgcn_sched_barrier(0);
    int r2 = r_, h2 = hi; asm volatile("" : "+v"(r2), "+v"(h2));
#pragma unroll
    for (int tb = 0; tb < 2; ++tb) {
        bf16x8 Pf[4];
#pragma unroll
        for (int ks = 0; ks < 4; ++ks) {
            const LAS bf16_t* rp = PmL + (32 * tb + r_) * 68 + 16 * ks;
            Pf[ks] = mk_frag(*(const LAS u32x2*)(rp + 4 * hi), *(const LAS u32x2*)(rp + 8 + 4 * hi));
        }
        float Gt[16]; ld_rowvec_lds(wl, tb, hi, Gt);
#pragma unroll
        for (int db = 0; db < 2; ++db) {
            f32x16 o = {};
#pragma unroll
            for (int ks = 0; ks < 4; ++ks) o = mfma32(Pf[ks], Uf[db][ks], o);
            st_frag(OL + (tb * 2 + db) * 1024, lane, o);
            f32x16 e = {};
#pragma unroll
            for (int ks = 0; ks < 4; ++ks) e = mfma32(Pf[ks], WfL[(db * 4 + ks) * 64 + lane], e);
            GAS bf16_t* qeb = QE + ((tb * 4 + 2 * db + (r2 >> 4)) * 64 + 32 * ((r2 >> 2) & 1) + 4 * h2) * 8 + 4 * ((r2 >> 3) & 1) + (r2 & 3);
#pragma unroll
            for (int g = 0; g < 16; ++g) {
                const int t = 32 * tb + (g & 3) + 8 * (g >> 2) + 4 * hi;
                const float qv = bf2f(gq[(size_t)(cr.r0 + cr.sgn * t) * 256 + h * 64 + 32 * db + r_]);
                qeb[((g & 3) + 8 * (g >> 2)) * 8] = f2bf(fexp(Gt[g]) * qv - e[g]);
            }
            __builtin_amdgcn_sched_barrier(0);
        }
    }
}

#define MIXA_TAIL_WORD(layer) (XCD_BAR_WORDS + 64 * (1 + (layer)))
template <int PASS> __device__ __forceinline__ void ph_mixA(int wv, int layer, LAS unsigned char* lds) {
    const Params p = load_params();
    PHASE_IDS();
    const int lane = tid_ & 63, wave = tid_ >> 6;
    LAS float* wl = (LAS float*)(lds + wave * 18176);
    if (PASS == 0) {
        const int gw = bid_ * 8 + wave, NGW = nblk_ * 8;
        for (int id = gw; id < 16 * 128; id += NGW) gdn_A_unit(p, layer, id >> 7, id & 127, lane, wl);
        for (int id = gw; id < 16 * 128; id += NGW) mlstm_A_unit(p, layer, id >> 7, id & 127, lane, wl);
    } else {
        const int first = nblk_ > 32 ? 32 : 0, nb = (nblk_ - first) < 16 ? (nblk_ - first) : 16;
        if (bid_ < first || bid_ >= first + nb) return;
        for (int id = (bid_ - first) * 8 + wave; id < 128; id += nb * 8) {
            const int dd = id >> 1;
            if (id & 1) mlstm_A_unit(p, layer, dd >> 2, 128 + (dd & 3), lane, wl); else gdn_A_unit(p, layer, dd >> 2, 128 + (dd & 3), lane, wl);
            asm volatile("s_waitcnt vmcnt(0)" ::: "memory");
            __builtin_amdgcn_fence(__ATOMIC_RELEASE, "agent");
            asm volatile("s_waitcnt vmcnt(0)" ::: "memory");
            if (lane == 0) (void)xb_add(&((unsigned*)(p.ws + OFF_BAR))[MIXA_TAIL_WORD(layer)], 1u);
        }
    }
}
__device__ __forceinline__ void mixA_tail_wait(const Params& p, int layer) {
    unsigned* w = &((unsigned*)(p.ws + OFF_BAR))[MIXA_TAIL_WORD(layer)];
    unsigned sp = 0u;
    while (xb_ld(w) < 128u) { __builtin_amdgcn_s_sleep(2); if (++sp > (1u << 22)) break; }
    __builtin_amdgcn_fence(__ATOMIC_ACQUIRE, "agent");
    asm volatile("s_waitcnt vmcnt(0)" ::: "memory");
}

__device__ __forceinline__ void ph_mixB(int wv, int layer, LAS unsigned char* lds) {
    const Params p = load_params();
    PHASE_IDS();
    if (bid_ >= 32) return;
    if ((tid_ >> 6) >= (bid_ < 16 ? 4 : 2)) return;
    const int lane = tid_ & 63, wave = tid_ >> 6, r_ = lane & 31, hi = lane >> 5;
    const int kind = bid_ >> 4, chain = bid_ & 15, db = wave & 1, tbs = wave >> 1;
    const int b = chain >> 3, h = (chain >> 1) & 3, dir = chain & 1;
    if (kind == 0) {
        LAS float* tab = (LAS float*)(lds + wave * 1024);
        const GAS bf16x8* QPb = (const GAS bf16x8*)(p.ws + OFF_MLQP) + (size_t)chain * NCHUNK * 512;
        GAS float* MLH = (GAS float*)(p.ws + OFF_MLH) + (size_t)dir * NROW * 256;
        const GAS float* VECb = (const GAS float*)(p.ws + OFF_MLVEC) + (size_t)chain * NCHUNK * 320;
        const GAS float* NUMb = (const GAS float*)(p.ws + OFF_MLNUM) + (size_t)chain * NCHUNK * 4096;
        const GAS float* KLb = (const GAS float*)(p.ws + OFF_MLKL) + (size_t)chain * NCHUNK * 4096;
        f32x16 C0 = {}, C1 = {};
        float nmine = 0.f, m = 0.f;
        tab[128 + lane] = 0.f;
        bf16x8 qf[4]; float Lt, bt, dt, mloc, Btot, nloc;
        auto prefetch = [&](int c) {
            const GAS float* VEC = VECb + (size_t)c * 320;
#pragma unroll
            for (int ks = 0; ks < 4; ++ks) qf[ks] = QPb[(size_t)c * 512 + (tbs * 4 + ks) * 64 + lane];
            dt = VEC[64 + 32 * tbs + r_]; Lt = VEC[128 + 32 * tbs + r_]; bt = VEC[192 + 32 * tbs + r_];
            nloc = VEC[lane]; mloc = VEC[256]; Btot = VEC[257];
        };
        prefetch(0);
        f32x16 k0 = ld_frag(KLb + (0 * 2 + db) * 1024, lane), k1 = ld_frag(KLb + (1 * 2 + db) * 1024, lane), nl = {};
        if (layer == 0) nl = ld_frag(NUMb + (tbs * 2 + db) * 1024, lane);
        for (int c = 0; c < NCHUNK; ++c) {
            const ChunkRows cr = chunk_rows(b, dir, c);
            const bool emit = (c >= 4 || layer == 0);
            const int cn = c + 1 < NCHUNK ? c + 1 : c;
            f32x16 qc = {};
            if (emit) {
                float pq = 0.f;
#pragma unroll
                for (int ks = 0; ks < 4; ++ks) {
                    const f32x4 na = *(const LAS f32x4*)(tab + 128 + 16 * ks + 4 * hi), nb = *(const LAS f32x4*)(tab + 128 + 16 * ks + 8 + 4 * hi);
#pragma unroll
                    for (int j = 0; j < 4; ++j) pq += bf2f((bf16_t)qf[ks][j]) * na[j] + bf2f((bf16_t)qf[ks][4 + j]) * nb[j];
                }
                pq += xor_lane<32>(pq);
                {
                    const float inter = bt + m, Mt = fmaxf(Lt, inter), sA = fexp(Lt - Mt), sB = fexp(inter - Mt);
                    const float rinv = __builtin_amdgcn_rcpf(fmaxf(fabsf(sA * dt + sB * pq), fexp(-Mt)));
                    tab[r_] = sA * rinv; tab[32 + r_] = sB * rinv;
                }
                bf16x8 Cf[4];
                Cf[0] = acc_frag<0>(C0); Cf[1] = acc_frag<1>(C0); Cf[2] = acc_frag<0>(C1); Cf[3] = acc_frag<1>(C1);
#pragma unroll
                for (int ks = 0; ks < 4; ++ks) qc = mfma32(qf[ks], Cf[ks], qc);
            }
            const float mnew = fmaxf(Btot + m, mloc), dec = fexp(Btot + m - mnew), wlc = fexp(mloc - mnew);
            nmine = dec * nmine + wlc * nloc; m = mnew;
            if (c + 1 == 128) mixA_tail_wait(p, layer);
            if (c + 1 < NCHUNK) prefetch(c + 1);
            if (emit) {
                GAS float* orow = MLH + (size_t)(cr.r0 + cr.sgn * (32 * tbs + 4 * hi)) * 256 + h * 64 + 32 * db + r_;
#pragma unroll
                for (int q = 0; q < 4; ++q) {
                    const f32x4 a4 = *(const LAS f32x4*)(tab + 8 * q + 4 * hi), b4 = *(const LAS f32x4*)(tab + 32 + 8 * q + 4 * hi);
#pragma unroll
                    for (int i = 0; i < 4; ++i) orow[(ptrdiff_t)cr.sgn * ((i + 8 * q) * 256)] = a4[i] * nl[4 * q + i] + b4[i] * qc[4 * q + i];
                }
            }
            if (cn >= 4 || layer == 0) nl = ld_frag(NUMb + (size_t)cn * 4096 + (tbs * 2 + db) * 1024, lane);
#pragma unroll
            for (int g = 0; g < 16; ++g) { C0[g] = dec * C0[g] + wlc * k0[g]; C1[g] = dec * C1[g] + wlc * k1[g]; }
            k0 = ld_frag(KLb + (size_t)cn * 4096 + (0 * 2 + db) * 1024, lane); k1 = ld_frag(KLb + (size_t)cn * 4096 + (1 * 2 + db) * 1024, lane);
            tab[128 + lane] = nmine;
        }
    } else {
        GAS float* GDO = (GAS float*)(p.ws + OFF_GDO) + (size_t)dir * NROW * 256;
        const GAS bf16_t* QEb = (const GAS bf16_t*)(p.ws + OFF_GDQE) + (size_t)chain * NCHUNK * 4096;
        const GAS bf16_t* MWb = (const GAS bf16_t*)(p.ws + OFF_GDMW) + (size_t)chain * NCHUNK * 4096;
        const GAS float* OLb = (const GAS float*)(p.ws + OFF_GDOL) + (size_t)chain * NCHUNK * 4096;
        const GAS float* NMb = (const GAS float*)(p.ws + OFF_GDN) + (size_t)chain * NCHUNK * 4096;
        const GAS float* SCb = (const GAS float*)(p.ws + OFF_GDSC) + (size_t)chain * NCHUNK;
        f32x16 S0 = {}, S1 = {}, N0, N1, O0 = {}, O1 = {};
        bf16x8 qe[2][4], mw[2][4]; float eL;
        auto prefetch = [&](int c) {
            const GAS bf16_t* QE = QEb + (size_t)c * 4096; const GAS bf16_t* MW = MWb + (size_t)c * 4096;
#pragma unroll
            for (int tb = 0; tb < 2; ++tb)
#pragma unroll
                for (int ks = 0; ks < 4; ++ks) {
                    qe[tb][ks] = *(const GAS bf16x8*)(QE + ((tb * 4 + ks) * 64 + lane) * 8);
                    mw[tb][ks] = *(const GAS bf16x8*)(MW + ((tb * 4 + ks) * 64 + lane) * 8);
                }
            eL = SCb[c];
        };
        prefetch(0);
        N0 = ld_frag(NMb + (0 * 2 + db) * 1024, lane); N1 = ld_frag(NMb + (1 * 2 + db) * 1024, lane);
        if (layer == 0) { O0 = ld_frag(OLb + (0 * 2 + db) * 1024, lane); O1 = ld_frag(OLb + (1 * 2 + db) * 1024, lane); }
        for (int c = 0; c < NCHUNK; ++c) {
            const ChunkRows cr = chunk_rows(b, dir, c);
            const bool emit = (c >= 4 || layer == 0);
            const int cn = c + 1 < NCHUNK ? c + 1 : c;
            bf16x8 Sf[4];
            Sf[0] = acc_frag<0>(S0); Sf[1] = acc_frag<1>(S0); Sf[2] = acc_frag<0>(S1); Sf[3] = acc_frag<1>(S1);
#pragma unroll
            for (int g = 0; g < 16; ++g) { N0[g] += eL * S0[g]; N1[g] += eL * S1[g]; }
            if (c + 1 == 128) mixA_tail_wait(p, layer);
            const f32x16 Nq0 = ld_frag(NMb + (size_t)cn * 4096 + (0 * 2 + db) * 1024, lane), Nq1 = ld_frag(NMb + (size_t)cn * 4096 + (1 * 2 + db) * 1024, lane);
#pragma unroll
            for (int ks = 0; ks < 4; ++ks) { N0 = mfma32(mw[0][ks], Sf[ks], N0); N1 = mfma32(mw[1][ks], Sf[ks], N1); }
            if (emit) {
#pragma unroll
                for (int ks = 0; ks < 4; ++ks) { O0 = mfma32(qe[0][ks], Sf[ks], O0); O1 = mfma32(qe[1][ks], Sf[ks], O1); }
            }
            f32x16 Oq0 = {}, Oq1 = {};
            if (cn >= 4 || layer == 0) { Oq0 = ld_frag(OLb + (size_t)cn * 4096 + (0 * 2 + db) * 1024, lane); Oq1 = ld_frag(OLb + (size_t)cn * 4096 + (1 * 2 + db) * 1024, lane); }
            prefetch(cn);
            if (emit) {
#pragma unroll
                for (int tb = 0; tb < 2; ++tb) {
                    const f32x16& o = tb ? O1 : O0;
                    GAS float* orow = GDO + (size_t)(cr.r0 + cr.sgn * (32 * tb + 4 * hi)) * 256 + h * 64 + 32 * db + r_;
#pragma unroll
                    for (int g = 0; g < 16; ++g) orow[(ptrdiff_t)cr.sgn * (((g & 3) + 8 * (g >> 2)) * 256)] = o[g];
                }
            }
            S0 = N0; S1 = N1; N0 = Nq0; N1 = Nq1; O0 = Oq0; O1 = Oq1;
        }
    }
}

__device__ __forceinline__ void ph_finish(int wv, int layer) {
    const Params p = load_params();
    PHASE_IDS();
    const int tid = tid_, lane = tid & 63, wave = tid >> 6;
    const int gw = bid_ * 8 + wave, NGW = nblk_ * 8;
    const GAS bf16_t* P = (const GAS bf16_t*)(p.ws + OFF_PB);
    const GAS float* MLH = (const GAS float*)(p.ws + OFF_MLH); const GAS float* GDO = (const GAS float*)(p.ws + OFF_GDO);
    GAS bf16_t* Y = (GAS bf16_t*)(p.ws + OFF_Y);
    const int nrows = layer == 0 ? NROW : NLAT;
    const int c4 = 4 * lane;
    const f32x4 mg = *(const f32x4*)(p.in[I_MLOG] + layer * 256 + c4), gg = *(const f32x4*)(p.in[I_GOG] + layer * 64 + (c4 & 63));
    {
        const GAS bf16_t* PO = (const GAS bf16_t*)(p.ws + OFF_APO); const GAS float* AML = (const GAS float*)(p.ws + OFF_AML);
        for (int task = gw; task < ATT_NSU * 32; task += NGW) {
            const int s = task >> 5, rr = (task & 31) * 8 + (lane >> 3), fu = 512 - ATT_NSU + s, hd = (fu >> 5) & 7, orow = (fu >> 8) * SEQ + (fu & 31) * 256 + rr;
            u32x4 ov[3]; float m[3], l[3];
#pragma unroll
            for (int k = 0; k < 3; ++k) {
                const int combo = s * 3 + k;
                ov[k] = *(const GAS u32x4*)(PO + ((size_t)(combo >> 4) * 256 + rr) * DM + (combo & 15) * 64 + 8 * (lane & 7));
                const f32x2 ml = *(const GAS f32x2*)(AML + ((size_t)combo * 256 + rr) * 2);
                m[k] = ml.x; l[k] = ml.y;
            }
            const float M = fmaxf(fmaxf(m[0], m[1]), m[2]);
            float w[3], W = 0.f;
#pragma unroll
            for (int k = 0; k < 3; ++k) { w[k] = l[k] * __builtin_amdgcn_exp2f(m[k] - M); W += w[k]; }
            const float rW = 1.f / W;
            float acc[8];
#pragma unroll
            for (int j = 0; j < 8; ++j) acc[j] = 0.f;
#pragma unroll
            for (int k = 0; k < 3; ++k) {
                float f[8]; unpack8(ov[k], f);
                const float wk = w[k] * rW;
#pragma unroll
                for (int j = 0; j < 8; ++j) acc[j] += wk * f[j];
            }
            *(GAS u32x4*)(Y + (size_t)orow * DM + hd * 64 + 8 * (lane & 7)) = pack8(acc);
        }
    }
    for (int r = gw; r < nrows; r += NGW) {
        const f32x4 h0 = *(const GAS f32x4*)(MLH + (size_t)r * 256 + c4), h1 = *(const GAS f32x4*)(MLH + (size_t)NROW * 256 + (size_t)r * 256 + c4);
        const f32x4 g0 = *(const GAS f32x4*)(GDO + (size_t)r * 256 + c4), g1 = *(const GAS f32x4*)(GDO + (size_t)NROW * 256 + (size_t)r * 256 + c4);
        const u32x2 ow = *(const GAS u32x2*)(P + (size_t)r * NPC + 1536 + c4), zw = *(const GAS u32x2*)(P + (size_t)r * NPC + 2560 + c4);
        const f32x4 hs = h0 + h1, os = g0 + g1;
        float s1 = hs.x * hs.x + hs.y * hs.y + hs.z * hs.z + hs.w * hs.w, s2 = os.x * os.x + os.y * os.y + os.z * os.z + os.w * os.w;
        s1 += xor_lane<1>(s1); s1 += xor_lane<2>(s1); s1 += xor_lane<4>(s1); s1 += xor_lane<8>(s1);
        s2 += xor_lane<1>(s2); s2 += xor_lane<2>(s2); s2 += xor_lane<4>(s2); s2 += xor_lane<8>(s2);
        const float r1 = rsqrtf(s1 * (1.f / 64.f) + EPS), r2 = rsqrtf(s2 * (1.f / 64.f) + EPS);
        const float og[4] = {__uint_as_float(ow.x << 16), __uint_as_float(ow.x & 0xffff0000u), __uint_as_float(ow.y << 16), __uint_as_float(ow.y & 0xffff0000u)};
        const float zg[4] = {__uint_as_float(zw.x << 16), __uint_as_float(zw.x & 0xffff0000u), __uint_as_float(zw.y << 16), __uint_as_float(zw.y & 0xffff0000u)};
        float ym[4], yg[4];
#pragma unroll
        for (int i = 0; i < 4; ++i) { ym[i] = sigmoidf_(og[i]) * hs[i] * r1 * mg[i]; yg[i] = os[i] * r2 * gg[i] * siluf(zg[i]); }
        u32x2 o; o.x = pk_bf16(ym[0], ym[1]); o.y = pk_bf16(ym[2], ym[3]);
        *(GAS u32x2*)(Y + (size_t)r * DM + 512 + c4) = o;
        o.x = pk_bf16(yg[0], yg[1]); o.y = pk_bf16(yg[2], yg[3]);
        *(GAS u32x2*)(Y + (size_t)r * DM + 768 + c4) = o;
    }
}

__device__ __forceinline__ void ph_route(int wv, int layer, LAS unsigned char* lds) {
    const Params p = load_params();
    PHASE_IDS();
    const int tid = tid_, lane = tid & 63, wave = tid >> 6;
    const int gw = bid_ * 8 + wave, NGW = nblk_ * 8;
    const float* MODV = (const float*)(p.ws + OFF_MODV) + (size_t)layer * 3 * NMOD;
    const float* ng = p.in[I_N2G] + (size_t)layer * DM;
    const bf16_t* X1 = (const bf16_t*)(p.ws + OFF_X1);
    GAS bf16_t* H2 = (GAS bf16_t*)(p.ws + OFF_XA);
    const GAS bf16_t* RWt = (const GAS bf16_t*)(p.ws + OFF_RWT) + (size_t)layer * NE * DM;
    GAS float* AFF = (GAS float*)(p.ws + OFF_AFF);
    const int nrows = layer == 0 ? NROW : NLAT;
    stage_bt<1>(RWt, lds, tid);
    for (int task = wave * nblk_ + bid_; task < nrows / 16; task += NGW) {
        const int row0 = task * 16;
        const float* mv = MODV + (size_t)row_sel(row0) * NMOD;
        f32x4 ga[4], sh[4];
#pragma unroll
        for (int j = 0; j < 4; ++j) {
            const int col = 4 * lane + 256 * j;
            const f32x4 g = *(const f32x4*)(ng + col), sc = *(const f32x4*)(mv + 4 * DM + col);
            sh[j] = *(const f32x4*)(mv + 3 * DM + col);
            ga[j] = g * (sc + (f32x4){1.f, 1.f, 1.f, 1.f});
        }
#pragma unroll 1
        for (int rb = 0; rb < 16; rb += 4) {
            f32x4 v[4][4];
#pragma unroll
            for (int q = 0; q < 4; ++q) {
                const bf16_t* xr = X1 + (size_t)(row0 + rb + q) * DM;
#pragma unroll
                for (int j = 0; j < 4; ++j) v[q][j] = ld4_bf16(xr + 4 * lane + 256 * j);
            }
#pragma unroll
            for (int q = 0; q < 4; ++q) {
                float ss = 0.f;
#pragma unroll
                for (int j = 0; j < 4; ++j) ss += v[q][j].x * v[q][j].x + v[q][j].y * v[q][j].y + v[q][j].z * v[q][j].z + v[q][j].w * v[q][j].w;
                const float rstd = rsqrtf(wave_sum(ss) * (1.f / DM) + EPS);
#pragma unroll
                for (int j = 0; j < 4; ++j) {
                    const f32x4 h = v[q][j] * rstd * ga[j] + sh[j];
                    u32x2 o; o.x = pk_bf16(h.x, h.y); o.y = pk_bf16(h.z, h.w);
                    *(GAS u32x2*)(H2 + (size_t)(row0 + rb + q) * DM + 4 * lane + 256 * j) = o;
                }
            }
        }
        __builtin_amdgcn_fence(__ATOMIC_RELEASE, "workgroup"); __builtin_amdgcn_fence(__ATOMIC_ACQUIRE, "workgroup");
        f32x4 acc[1];
        skinny_proj_l<1>(H2 + (size_t)row0 * DM, lds, lane, acc);
#pragma unroll
        for (int i = 0; i < 4; ++i) {
            float mx = acc[0][i];
            mx = fmaxf(mx, xor_lane<1>(mx)); mx = fmaxf(mx, xor_lane<2>(mx)); mx = fmaxf(mx, xor_lane<4>(mx)); mx = fmaxf(mx, xor_lane<8>(mx));
            const float ex = expf(acc[0][i] - mx);
            float se = ex;
            se += xor_lane<1>(se); se += xor_lane<2>(se); se += xor_lane<4>(se); se += xor_lane<8>(se);
            AFF[(size_t)(lane & 15) * NROW + row0 + 4 * (lane >> 4) + i] = ex / se;
        }
    }
}

__device__ __forceinline__ void ph_topk(int wv, int layer, LAS unsigned char* lds) {
    const Params p = load_params();
    int wv_ = __builtin_amdgcn_readfirstlane(wv); asm volatile("" : "+s"(wv_)); int tid_; { int l_; asm volatile("v_mbcnt_lo_u32_b32 %0, -1, 0\n\tv_mbcnt_hi_u32_b32 %0, -1, %0" : "=v"(l_)); tid_ = wv_ * 64 + l_; } int bid_ = blockIdx.x; asm volatile("" : "+s"(bid_)); int nblk_ = gridDim.x; asm volatile("" : "+s"(nblk_));
    const int tid = tid_, lane = tid & 63, wave = tid >> 6;
    LAS unsigned* keys = (LAS unsigned*)lds;
    LAS unsigned* hist = keys + 8192 + 256;
    LAS unsigned* sh = hist + 2048;
    const float* AFF = (const float*)(p.ws + OFF_AFF);
    int* IDX = (int*)(p.ws + OFF_IDX); float* VALS = (float*)(p.ws + OFF_VALS); int* SLOT = (int*)(p.ws + OFF_SLOT);
    const int nprob = layer == 0 ? 64 : 32;
    for (int pr = bid_; pr < nprob; pr += nblk_) {
        const bool isctx = pr >= 32; const int q = pr & 31, b = q >> 4, e = q & 15;
        const int N = isctx ? CTXL : SEQ, cap = isctx ? CAPC : CAPL, row0 = isctx ? NLAT + b * CTXL : b * SEQ;
        for (int n = tid; n < N; n += 512) keys[n + (n >> 5)] = __float_as_uint(AFF[(size_t)e * NROW + row0 + n]);
        unsigned prefix = 0, need = (unsigned)cap;
#pragma unroll 1
        for (int pass = 0; pass < 3; ++pass) {
            const int shift = pass == 0 ? 21 : (pass == 1 ? 10 : 0), bits = pass == 2 ? 10 : 11;
            const unsigned bmask = (1u << bits) - 1u;
            for (int i = tid; i < 2048; i += 512) hist[i] = 0;
            __syncthreads();
            for (int n = tid; n < N; n += 512) {
                const unsigned k = keys[n + (n >> 5)];
                if (pass == 0 || (k >> (shift + bits)) == (prefix >> (shift + bits))) atomicAdd((unsigned*)&hist[(k >> shift) & bmask], 1u);
            }
            __syncthreads();
            if (wave == 0) {
                unsigned mine = 0;
#pragma unroll
                for (int i = 0; i < 32; ++i) mine += hist[32 * lane + i];
                unsigned suf = mine;
#pragma unroll
                for (int o = 1; o < 64; o <<= 1) { const unsigned t = (unsigned)__builtin_amdgcn_ds_bpermute((lane + o) << 2, (int)suf); if (lane + o < 64) suf += t; }
                const unsigned above = suf - mine;
                if (above < need && suf >= need) {
                    unsigned cum = above; int bin = 32 * lane;
                    for (int i = 31; i >= 0; --i) { const unsigned cnt = hist[32 * lane + i]; if (cum + cnt >= need) { bin = 32 * lane + i; break; } cum += cnt; }
                    sh[0] = prefix | ((unsigned)bin << shift); sh[1] = need - cum;
                }
            }
            __syncthreads();
            prefix = sh[0]; need = sh[1];
            __syncthreads();
        }
        const unsigned T = prefix, need_eq = need;
        const int per = (N + 511) / 512, n0 = tid * per, n1 = min(N, n0 + per);
        unsigned cgt = 0, ceq = 0;
        for (int n = n0; n < n1; ++n) { const unsigned k = keys[n + (n >> 5)]; cgt += (k > T); ceq += (k == T); }
        unsigned igt = cgt, ieq = ceq;
#pragma unroll
        for (int o = 1; o < 64; o <<= 1) { const unsigned a = (unsigned)__builtin_amdgcn_ds_bpermute((lane - o) << 2, (int)igt), c = (unsigned)__builtin_amdgcn_ds_bpermute((lane - o) << 2, (int)ieq); if (lane >= o) { igt += a; ieq += c; } }
        if (lane == 63) { sh[16 + wave] = igt; sh[32 + wave] = ieq; }
        __syncthreads();
        unsigned bgt = igt - cgt, beq = ieq - ceq;
        for (int w = 0; w < wave; ++w) { bgt += sh[16 + w]; beq += sh[32 + w]; }
        for (int n = n0; n < n1; ++n) {
            const unsigned k = keys[n + (n >> 5)];
            const bool sel = (k > T) || (k == T && beq < need_eq);
            const unsigned slot = bgt + min(beq, need_eq);
            if (sel) {
                const int hr = isctx ? NB * NE * CAPL + (e * 2 + b) * CAPC + (int)slot : (e * 2 + b) * CAPL + (int)slot;
                IDX[hr] = row0 + n; VALS[hr] = __uint_as_float(k);
                SLOT[(size_t)e * NROW + row0 + n] = (int)slot;
            } else SLOT[(size_t)e * NROW + row0 + n] = -1;
            bgt += (k > T); beq += (k == T);
        }
        __syncthreads();
    }
}

__device__ __forceinline__ void ph_combine(int wv, int layer) {
    const Params p = load_params();
    PHASE_IDS();
    const int tid = tid_, lane = tid & 63, wave = tid >> 6;
    const int gw = bid_ * 8 + wave, NGW = nblk_ * 8;
    const float* MODV = (const float*)(p.ws + OFF_MODV) + (size_t)layer * 3 * NMOD;
    const bf16_t* X1 = (const bf16_t*)(p.ws + OFF_X1); const GAS bf16_t* YE = (const GAS bf16_t*)(p.ws + OFF_YE);
    const GAS int* SLOT = (const GAS int*)(p.ws + OFF_SLOT);
    const int nrows = layer == 0 ? NROW : NLAT;
    for (int r = gw; r < nrows; r += NGW) {
        const bool lat = r < NLAT;
        const int b = lat ? (r >> 13) : ((r - NLAT) >> 8);
        const float* g2 = MODV + (size_t)row_sel(r) * NMOD + 5 * DM;
        const int myslot = lane < NE ? SLOT[(size_t)lane * NROW + r] : -1;
        unsigned long long mask = __ballot(myslot >= 0);
        f32x4 xv[4];
#pragma unroll
        for (int j = 0; j < 4; ++j) xv[j] = ld4_bf16(X1 + (size_t)r * DM + 4 * lane + 256 * j);
        f32x4 acc[4];
#pragma unroll
        for (int j = 0; j < 4; ++j) acc[j] = (f32x4){0.f, 0.f, 0.f, 0.f};
        while (mask) {
            const int e = __builtin_ctzll(mask); mask &= mask - 1;
            const int s = __builtin_amdgcn_readlane(myslot, e);
            const int nq = lat ? 1 : 4;
            const GAS bf16_t* yr = lat ? YE + (size_t)((e * 2 + b) * CAPL + s) * DM : (const GAS bf16_t*)(p.ws + OFF_YEC) + (size_t)((e * 2 + b) * CAPC + s) * DM;
            for (int q = 0; q < nq; ++q) {
#pragma unroll
                for (int j = 0; j < 4; ++j) {
                    const u32x2 w = *(const GAS u32x2*)(yr + (size_t)q * 1024 * DM + 4 * lane + 256 * j);
                    acc[j] += (f32x4){__uint_as_float(w.x << 16), __uint_as_float(w.x & 0xffff0000u), __uint_as_float(w.y << 16), __uint_as_float(w.y & 0xffff0000u)};
                }
            }
        }
#pragma unroll
        for (int j = 0; j < 4; ++j) {
            const int col = 4 * lane + 256 * j;
            const f32x4 gv = *(const f32x4*)(g2 + col);
            const f32x4 o = xv[j] + gv * acc[j];
            if (layer == 0) st4_bf16((bf16_t*)(p.ws + OFF_X2) + (size_t)r * DM + col, o);
            else __builtin_nontemporal_store(o, (f32x4*)(p.out + (size_t)r * DM + col));
        }
    }
}

__device__ __forceinline__ void xcd_barrier_post(int wv, LAS unsigned char* lds) {
    const Params p = load_params();
    PHASE_IDS();
    volatile LAS unsigned* st = (volatile LAS unsigned*)(lds + LDS_MAIN);
    if (tid_ == 0) { st[0] = 0u; st[1] = 0u; (void)xb_add(&((unsigned*)(p.ws + OFF_BAR))[XB_XCNT(xb_xcc_id())], 1u); }
    __syncthreads();
    (void)bid_; (void)nblk_;
}
__device__ __forceinline__ void xcd_barrier_complete(unsigned* bar, unsigned x, unsigned G, unsigned& nloc, unsigned& nx) {
    unsigned sum, cnt, mine, sp = 0u;
    for (;;) {
        sum = 0u; cnt = 0u; mine = 0u;
#pragma unroll
        for (unsigned j = 0; j < 16; ++j) { const unsigned c = xb_ld(&bar[XB_XCNT(j)]); sum += c; cnt += (c > 0u) ? 1u : 0u; mine = (j == x) ? c : mine; }
        if (sum == G) break;
        __builtin_amdgcn_s_sleep(1);
        if ((++sp & 255u) == 0u) { if (xb_ld(&bar[XB_TMO])) break; if (sp > XB_SPIN_CAP) { atomicAdd(&bar[XB_TMO], 1u); break; } }
    }
    nloc = mine > 0u ? mine : 1u; nx = cnt > 0u ? cnt : 1u;
}
__device__ __forceinline__ void grid_barrier(int wv, LAS unsigned char* lds) {
    const Params p = load_params();
    PHASE_IDS();
    asm volatile("s_waitcnt vmcnt(0)" ::: "memory");
    __syncthreads();
    if (tid_ == 0) {
        unsigned* bar = (unsigned*)(p.ws + OFF_BAR);
        volatile LAS unsigned* st = (volatile LAS unsigned*)(lds + LDS_MAIN);
        const unsigned x = xb_xcc_id();
        __builtin_amdgcn_s_waitcnt(0);
        unsigned nloc = st[0], nx = st[1];
        if (nloc == 0u) { xcd_barrier_complete(bar, x, (unsigned)nblk_, nloc, nx); st[0] = nloc; st[1] = nx; }
        const unsigned old = xb_add(&bar[XB_XSUB(x)], 1u);
        const unsigned gen = old / nloc;
        if (old + 1u == (gen + 1u) * nloc) {
            __builtin_amdgcn_fence(__ATOMIC_RELEASE, "agent");
            asm volatile("s_waitcnt vmcnt(0)" ::: "memory");
            const unsigned og = xb_add(&bar[XB_TOP], 1u);
            const unsigned tg = og / nx;
            if (og + 1u == (tg + 1u) * nx) xb_add(&bar[XB_TOPGEN], 1u);
            else XB_SPIN(xb_ld(&bar[XB_TOPGEN]) == tg, bar);
            __builtin_amdgcn_fence(__ATOMIC_ACQUIRE, "agent");
            asm volatile("s_waitcnt vmcnt(0)" ::: "memory");
        } else {
            XB_SPIN(xb_ld(&bar[XB_TOPGEN]) == gen, bar);
            __builtin_amdgcn_fence(__ATOMIC_ACQUIRE, "agent");
            asm volatile("s_waitcnt vmcnt(0)" ::: "memory");
        }
    }
    __syncthreads();
    (void)bid_;
}

#ifndef PHMASK
#define PHMASK 0xffff
#endif
#define PHON(i) ((PHMASK >> (i)) & 1)
#ifndef DUP_MASK
#define DUP_MASK 0u
#endif
#define PH(i, call) do { if (PHON(i)) { call; if ((DUP_MASK >> (i)) & 1u) { int nrep_ = 8; asm volatile("" : "+s"(nrep_)); for (int k_ = 0; k_ < nrep_; ++k_) { __syncthreads(); call; } } } } while (0)
template <int layer> __device__ __forceinline__ void run_layer(const int wv, LAS unsigned char* lds, cooperative_groups::grid_group& grid) {
        PH(2, ph_norm1(wv, layer, lds));
        grid_barrier(wv, lds);
        PH(3, ph_gemm_in(wv, layer, lds));
        grid_barrier(wv, lds);
        PH(4, ph_prep(wv, layer));
        grid_barrier(wv, lds);
        PH(6, ph_mixA<0>(wv, layer, lds));
        grid_barrier(wv, lds);
        PH(15, ph_mixA<1>(wv, layer, lds));
        __syncthreads();
        PH(14, ph_mixB(wv, layer, lds));
        PH(5, ph_attn(wv, layer, lds));
        grid_barrier(wv, lds);
        PH(7, ph_finish(wv, layer));
        grid_barrier(wv, lds);
        PH(8, ph_gemm_out(wv, layer, lds));
        grid_barrier(wv, lds);
        PH(9, ph_route(wv, layer, lds));
        grid_barrier(wv, lds);
        PH(10, ph_topk(wv, layer, lds));
        grid_barrier(wv, lds);
        PH(11, ph_moe1(wv, layer, lds));
        grid_barrier(wv, lds);
        PH(12, ph_moe2(wv, layer, lds));
        grid_barrier(wv, lds);
        PH(13, ph_combine(wv, layer));
        if (layer == 0) grid_barrier(wv, lds);}

namespace cg = cooperative_groups;
__global__ void __launch_bounds__(512) fwd_mega(Params p) {
    extern __shared__ __attribute__((aligned(16))) unsigned char lds_raw[];
    LAS unsigned char* lds = (LAS unsigned char*)lds_raw;
    cg::grid_group grid = cg::this_grid();
    const int wv = __builtin_amdgcn_readfirstlane((int)(threadIdx.x >> 6));
    xcd_barrier_post(wv, lds);
    PH(0, ph_convert(wv, lds));
    __syncthreads();
    PH(1, ph_mod(wv, lds));
    if (p.phase == 0x5eed) grid.sync(); else grid_barrier(wv, lds);
    run_layer<0>(wv, lds, grid);
    run_layer<1>(wv, lds, grid);
}

extern "C" void kernel_launch(void* const* d_in, const int* in_sizes, int n_in, void* d_out, int out_size, void* d_ws, size_t ws_size, hipStream_t stream) {
    static int grid_blocks = 0;
    if (grid_blocks == 0) {
        grid_blocks = -1;
        int dev = 0, cus = 0, per_cu = 0;
        if (n_in != 23 || ws_size < WS_NEED) { fprintf(stderr, "kernel_launch: unexpected n_in %d / ws_size %zu (need %zu)\n", n_in, ws_size, (size_t)WS_NEED); return; }
        if (hipFuncSetAttribute((const void*)fwd_mega, hipFuncAttributeMaxDynamicSharedMemorySize, LDS_BYTES) != hipSuccess) { fprintf(stderr, "kernel_launch: hipFuncSetAttribute failed\n"); return; }
        if (hipGetDevice(&dev) != hipSuccess || hipDeviceGetAttribute(&cus, hipDeviceAttributeMultiprocessorCount, dev) != hipSuccess) { fprintf(stderr, "kernel_launch: device query failed\n"); return; }
        if (hipOccupancyMaxActiveBlocksPerMultiprocessor(&per_cu, (const void*)fwd_mega, 512, LDS_BYTES) != hipSuccess || per_cu < 1) { fprintf(stderr, "kernel_launch: occupancy query failed (%d)\n", per_cu); return; }
        grid_blocks = cus * 1;
        fprintf(stderr, "kernel_launch: cus %d per_cu %d grid %d\n", cus, per_cu, grid_blocks);
    }
    if (grid_blocks < 0) return;
    Params p{};
    for (int i = 0; i < 23; ++i) p.in[i] = (const float*)d_in[i];
    p.out = (float*)d_out; p.ws = (unsigned char*)d_ws; p.phase = -1; p.layer = 0;
    if (hipMemsetAsync((char*)d_ws + OFF_CTL, 0, CTL_BYTES, stream) != hipSuccess) { fprintf(stderr, "kernel_launch: memset of control words failed\n"); return; }
    void* args[] = {&p};
    hipError_t e = hipLaunchCooperativeKernel((const void*)fwd_mega, dim3(grid_blocks), dim3(512), args, LDS_BYTES, stream);
    if (e != hipSuccess) fprintf(stderr, "cooperative launch failed: %s (grid %d)\n", hipGetErrorString(e), grid_blocks);
}
```
